# Optimizing an MI355X kernel written in HIP

```python
import math
import jax
import jax.numpy as jnp
from jax import lax
import numpy as np

D_MODEL = 1024
BATCH = 8
SEQ = 4096
DEPTH = 1

GRID_W = 64
CTX_LEN = 256
LRU_WIDTH = 512
LRU_BLOCKS = 8
LRU_BLOCK_W = LRU_WIDTH // LRU_BLOCKS
LRU_C = 8.0
CONV_W = 4
CONV_PAD_LO = 1
ATT_HEADS = 4
HEAD_DIM = 64
V_DIM = 2 * HEAD_DIM
QK_WIDTH = ATT_HEADS * 2 * HEAD_DIM
ATT_WIDTH = ATT_HEADS * V_DIM
MIX_WIDTH = LRU_WIDTH + ATT_WIDTH
IN_WIDTH = 2 * LRU_WIDTH + 2 * QK_WIDTH + ATT_WIDTH
ROPE_AXIS_DIM = HEAD_DIM // 2
ROPE_PAIRS = ROPE_AXIS_DIM // 2
ROPE_BASE = 10000.0
Q_BLOCK = 128
N_EXPERTS = 16
EC_FACTOR = 2
D_EXPERT = 2816
N_MOD = 6
EPS = 1e-6

kernel_name = "hybrid_rglru_diffattn_ecmoe_dit"


def rmsnorm(x, g):
    xf = x.astype(jnp.float32)
    y = xf * lax.rsqrt(jnp.mean(xf * xf, axis=-1, keepdims=True) + EPS)
    return (y * g.astype(jnp.float32)).astype(x.dtype)


def adaln(cvec, w, b, n_chunks):
    cols = n_chunks * D_MODEL
    m = jax.nn.silu(cvec) @ w[:, :cols] + b[:cols]
    return m.reshape(cvec.shape[0], n_chunks, D_MODEL)


def modulate(h, shift, scale):
    return h * (1 + scale[:, None]) + shift[:, None]


def split_cols(p):
    o1 = LRU_WIDTH
    o2 = 2 * LRU_WIDTH
    o3 = o2 + QK_WIDTH
    o4 = o3 + QK_WIDTH
    return p[..., :o1], p[..., o1:o2], p[..., o2:o3], p[..., o3:o4], p[..., o4:]


def axial_rope_tables(n):
    rows = n // GRID_W
    row = jnp.repeat(jnp.arange(rows), GRID_W).astype(jnp.float32)
    col = jnp.tile(jnp.arange(GRID_W), rows).astype(jnp.float32)
    inv = ROPE_BASE ** (-jnp.arange(ROPE_PAIRS, dtype=jnp.float32) / ROPE_PAIRS)
    ang_r = row[:, None] * inv
    ang_c = col[:, None] * inv
    return jnp.cos(ang_r), jnp.sin(ang_r), jnp.cos(ang_c), jnp.sin(ang_c)


def rope_axis(x, cos, sin):
    cos = cos[:, None, None, :].astype(x.dtype)
    sin = sin[:, None, None, :].astype(x.dtype)
    x1, x2 = x[..., :ROPE_PAIRS], x[..., ROPE_PAIRS:]
    return jnp.concatenate([x1 * cos - x2 * sin, x1 * sin + x2 * cos], axis=-1)


def apply_axial_rope(x, tabs):
    cr, sr, cc, sc = tabs
    return jnp.concatenate([rope_axis(x[..., :ROPE_AXIS_DIM], cr, sr),
                            rope_axis(x[..., ROPE_AXIS_DIM:], cc, sc)], axis=-1)


def centred_depthwise_conv(x, w, b):
    n = x.shape[1]
    xp = jnp.pad(x, ((0, 0), (CONV_PAD_LO, CONV_W - 1 - CONV_PAD_LO), (0, 0)))
    return sum(xp[:, k:k + n] * w[k] for k in range(CONV_W)) + b


def block_diag(x, w, b):
    xb = x.reshape(x.shape[:-1] + (LRU_BLOCKS, LRU_BLOCK_W))
    y = jnp.einsum("bsnw,nwv->bsnv", xb, w) + b
    return y.reshape(x.shape)


def rglru_gates(xc, wa, ba, wi, bi, lam, reset_first):
    r = jax.nn.sigmoid(block_diag(xc, wa, ba)).astype(jnp.float32)
    i = jax.nn.sigmoid(block_diag(xc, wi, bi)).astype(jnp.float32)
    log_a = -LRU_C * r * jax.nn.softplus(-lam.astype(jnp.float32))
    a = jnp.exp(log_a)
    mult = jnp.sqrt(-jnp.expm1(2.0 * log_a))
    if reset_first:
        mult = mult.at[:, 0].set(1.0)
    return a, mult * i * xc.astype(jnp.float32)


def _combine(e1, e2):
    a1, b1 = e1
    a2, b2 = e2
    return a1 * a2, a2 * b1 + b2


def linear_scan(a, u, h0=None):
    if h0 is not None:
        u = u.at[:, 0].add(a[:, 0] * h0)
    _, h = lax.associative_scan(_combine, (a, u), axis=1)
    return h


def rglru_direction(xc_ctx, xc_lat, wa, ba, wi, bi, lam, reverse):
    if reverse:
        xc_ctx = xc_ctx[:, ::-1]
        xc_lat = xc_lat[:, ::-1]
    a_c, u_c = rglru_gates(xc_ctx, wa, ba, wi, bi, lam, True)
    h_c = linear_scan(a_c, u_c)
    a_l, u_l = rglru_gates(xc_lat, wa, ba, wi, bi, lam, False)
    h_l = linear_scan(a_l, u_l, h_c[:, -1])
    if reverse:
        return h_c[:, ::-1], h_l[:, ::-1]
    return h_c, h_l


def diff_attention(q, k, v, lam):
    B, n = q.shape[:2]
    nb = n // Q_BLOCK
    scale = HEAD_DIM ** -0.5
    qb = jnp.moveaxis(q.reshape((B, nb, Q_BLOCK) + q.shape[2:]), 1, 0)

    def block(qblk):
        s = jnp.einsum("bqhcd,bkhcd->bhcqk", qblk, k).astype(jnp.float32) * scale
        p = jax.nn.softmax(s, axis=-1)
        w = (p[:, :, 0] - lam * p[:, :, 1]).astype(v.dtype)
        return jnp.einsum("bhqk,bkhe->bqhe", w, v)

    o = lax.map(block, qb)
    return jnp.moveaxis(o, 0, 1).reshape(B, n, ATT_HEADS, V_DIM)


def hybrid_mixer(hl, hc, rope, w_in, conv_w, conv_b, lru_wa, lru_ba, lru_wi, lru_bi, lru_lambda,
                 q_g, k_g, lq1, lk1, lq2, lk2, subln_g, lam_init, ctx_out):
    B, n, _ = hl.shape
    L = hc.shape[1]
    w_x, w_gate, w_q, w_k, w_v = split_cols(w_in)
    x_l, gate_l, q_l, k_l, v_l = split_cols(hl @ w_in)
    x_c, k_c, v_c = hc @ w_x, hc @ w_k, hc @ w_v

    xl_conv = centred_depthwise_conv(x_l, conv_w, conv_b)
    xc_conv = centred_depthwise_conv(x_c, conv_w, conv_b)
    hf_c, hf_l = rglru_direction(xc_conv, xl_conv, lru_wa[0], lru_ba[0], lru_wi[0], lru_bi[0],
                                 lru_lambda[0], False)
    hb_c, hb_l = rglru_direction(xc_conv, xl_conv, lru_wa[1], lru_ba[1], lru_wi[1], lru_bi[1],
                                 lru_lambda[1], True)
    lru_l = (hf_l + hb_l).astype(hl.dtype) * jax.nn.gelu(gate_l)

    f32 = jnp.float32
    lam = (jnp.exp(jnp.sum(lq1.astype(f32) * lk1.astype(f32)))
           - jnp.exp(jnp.sum(lq2.astype(f32) * lk2.astype(f32))) + lam_init)
    q_l = apply_axial_rope(rmsnorm(q_l.reshape(B, n, ATT_HEADS, 2, HEAD_DIM), q_g), rope)
    k_l = apply_axial_rope(rmsnorm(k_l.reshape(B, n, ATT_HEADS, 2, HEAD_DIM), k_g), rope)
    k_c = rmsnorm(k_c.reshape(B, L, ATT_HEADS, 2, HEAD_DIM), k_g)
    v_l = v_l.reshape(B, n, ATT_HEADS, V_DIM)
    v_c = v_c.reshape(B, L, ATT_HEADS, V_DIM)
    k_all = jnp.concatenate([k_c, k_l], axis=1)
    v_all = jnp.concatenate([v_c, v_l], axis=1)
    att_l = diff_attention(q_l, k_all, v_all, lam)
    att_l = (rmsnorm(att_l, subln_g) * (1 - lam_init)).reshape(B, n, ATT_WIDTH)
    out_l = jnp.concatenate([lru_l, att_l], axis=-1)
    if not ctx_out:
        return out_l, None

    lru_c = (hf_c + hb_c).astype(hc.dtype) * jax.nn.gelu(hc @ w_gate)
    q_c = rmsnorm((hc @ w_q).reshape(B, L, ATT_HEADS, 2, HEAD_DIM), q_g)
    att_c = diff_attention(q_c, k_c, v_c, lam)
    att_c = (rmsnorm(att_c, subln_g) * (1 - lam_init)).reshape(B, L, ATT_WIDTH)
    return out_l, jnp.concatenate([lru_c, att_c], axis=-1)


def expert_choice_ffn(h, w_router, w_gate, w_up, w_down):
    B, n, D = h.shape
    cap = EC_FACTOR * n // N_EXPERTS
    aff = jax.nn.softmax((h @ w_router).astype(jnp.float32), axis=-1)
    g, idx = lax.top_k(jnp.swapaxes(aff, 1, 2), cap)
    xe = jax.vmap(lambda hb, ib: hb[ib])(h, idx)

    def expert(args):
        xk, wg, wu, wd = args
        return (jax.nn.silu(xk @ wg) * (xk @ wu)) @ wd

    ye = lax.map(expert, (jnp.swapaxes(xe, 0, 1), w_gate, w_up, w_down))
    ye = jnp.swapaxes(ye, 0, 1) * g[..., None].astype(h.dtype)
    return jax.vmap(lambda yb, ib: jnp.zeros((n, D), yb.dtype).at[ib.reshape(-1)].add(yb.reshape(-1, D)))(ye, idx)


def setup_inputs(seed: int = 0) -> dict:
    key = jax.random.key(seed)
    ks = jax.random.split(key, 28)
    f32 = jnp.float32

    def nrm(k, shape, s):
        return jax.random.normal(k, shape, f32) * s

    a0 = jax.random.uniform(ks[14], (DEPTH, 2, LRU_WIDTH), f32, 0.9, 0.999)
    s0 = a0 ** (1.0 / LRU_C)
    return {
        "x": nrm(ks[0], (BATCH, SEQ, D_MODEL), 1.0),
        "c": nrm(ks[1], (BATCH, D_MODEL), 1.0),
        "ctx": nrm(ks[2], (BATCH, CTX_LEN, D_MODEL), 1.0),
        "c_ctx": nrm(ks[3], (D_MODEL,), 1.0),
        "w_ada": nrm(ks[4], (DEPTH, D_MODEL, N_MOD * D_MODEL), 0.5 * D_MODEL ** -0.5),
        "b_ada": nrm(ks[5], (DEPTH, N_MOD * D_MODEL), 0.02),
        "norm1_g": 1.0 + nrm(ks[6], (DEPTH, D_MODEL), 0.02),
        "norm2_g": 1.0 + nrm(ks[7], (DEPTH, D_MODEL), 0.02),
        "w_in": nrm(ks[8], (DEPTH, D_MODEL, IN_WIDTH), D_MODEL ** -0.5),
        "conv_w": nrm(ks[9], (DEPTH, CONV_W, LRU_WIDTH), CONV_W ** -0.5),
        "conv_b": nrm(ks[10], (DEPTH, LRU_WIDTH), 0.02),
        "lru_wa": nrm(ks[11], (DEPTH, 2, LRU_BLOCKS, LRU_BLOCK_W, LRU_BLOCK_W), LRU_BLOCK_W ** -0.5),
        "lru_ba": nrm(ks[12], (DEPTH, 2, LRU_BLOCKS, LRU_BLOCK_W), 0.02),
        "lru_wi": nrm(ks[13], (DEPTH, 2, LRU_BLOCKS, LRU_BLOCK_W, LRU_BLOCK_W), LRU_BLOCK_W ** -0.5),
        "lru_bi": nrm(ks[15], (DEPTH, 2, LRU_BLOCKS, LRU_BLOCK_W), 0.02),
        "lru_lambda": jnp.log(s0) - jnp.log1p(-s0),
        "q_norm_g": 1.0 + nrm(ks[16], (DEPTH, HEAD_DIM), 0.02),
        "k_norm_g": 1.0 + nrm(ks[17], (DEPTH, HEAD_DIM), 0.02),
        "lambda_q1": nrm(ks[18], (DEPTH, HEAD_DIM), 0.1),
        "lambda_k1": nrm(ks[19], (DEPTH, HEAD_DIM), 0.1),
        "lambda_q2": nrm(ks[20], (DEPTH, HEAD_DIM), 0.1),
        "lambda_k2": nrm(ks[21], (DEPTH, HEAD_DIM), 0.1),
        "subln_g": 1.0 + nrm(ks[22], (DEPTH, V_DIM), 0.02),
        "w_out": nrm(ks[23], (DEPTH, MIX_WIDTH, D_MODEL), MIX_WIDTH ** -0.5),
        "w_router": nrm(ks[24], (DEPTH, D_MODEL, N_EXPERTS), D_MODEL ** -0.5),
        "w_gate": nrm(ks[25], (DEPTH, N_EXPERTS, D_MODEL, D_EXPERT), D_MODEL ** -0.5),
        "w_up": nrm(ks[26], (DEPTH, N_EXPERTS, D_MODEL, D_EXPERT), D_MODEL ** -0.5),
        "w_down": nrm(ks[27], (DEPTH, N_EXPERTS, D_EXPERT, D_MODEL), D_EXPERT ** -0.5),
    }


def reference(x, c, ctx, c_ctx, w_ada, b_ada, norm1_g, norm2_g, w_in, conv_w, conv_b,
              lru_wa, lru_ba, lru_wi, lru_bi, lru_lambda, q_norm_g, k_norm_g,
              lambda_q1, lambda_k1, lambda_q2, lambda_k2, subln_g, w_out,
              w_router, w_gate, w_up, w_down):
    n = x.shape[1]
    rope = axial_rope_tables(n)
    for layer in range(DEPTH):
        last = layer == DEPTH - 1
        lam_init = 0.8 - 0.6 * math.exp(-0.3 * layer)
        mod_l = adaln(c, w_ada[layer], b_ada[layer], N_MOD)
        mod_c = adaln(c_ctx[None], w_ada[layer], b_ada[layer], 2 if last else N_MOD)
        hl = modulate(rmsnorm(x, norm1_g[layer]), mod_l[:, 0], mod_l[:, 1])
        hc = modulate(rmsnorm(ctx, norm1_g[layer]), mod_c[:, 0], mod_c[:, 1])
        mix_l, mix_c = hybrid_mixer(hl, hc, rope, w_in[layer], conv_w[layer], conv_b[layer],
                                    lru_wa[layer], lru_ba[layer], lru_wi[layer], lru_bi[layer],
                                    lru_lambda[layer], q_norm_g[layer], k_norm_g[layer],
                                    lambda_q1[layer], lambda_k1[layer], lambda_q2[layer],
                                    lambda_k2[layer], subln_g[layer], lam_init, not last)
        x = x + mod_l[:, 2][:, None] * (mix_l @ w_out[layer])
        h2 = modulate(rmsnorm(x, norm2_g[layer]), mod_l[:, 3], mod_l[:, 4])
        x = x + mod_l[:, 5][:, None] * expert_choice_ffn(h2, w_router[layer], w_gate[layer],
                                                         w_up[layer], w_down[layer])
        if not last:
            ctx = ctx + mod_c[:, 2][:, None] * (mix_c @ w_out[layer])
            h2c = modulate(rmsnorm(ctx, norm2_g[layer]), mod_c[:, 3], mod_c[:, 4])
            ctx = ctx + mod_c[:, 5][:, None] * expert_choice_ffn(h2c, w_router[layer], w_gate[layer],
                                                                 w_up[layer], w_down[layer])
    return x
```

```cpp
#include <hip/hip_runtime.h>
#include <cstdio>
#include <cstdint>

#ifndef MK_N_LAUNCHES
#define MK_N_LAUNCHES 1
#endif

#define GAS __attribute__((address_space(1)))
#define LAS __attribute__((address_space(3)))
typedef unsigned short bf16_t;
typedef short bf16x8 __attribute__((ext_vector_type(8)));
typedef float f32x4 __attribute__((ext_vector_type(4)));
typedef float f32x2 __attribute__((ext_vector_type(2)));
typedef unsigned u32x4 __attribute__((ext_vector_type(4)));
typedef unsigned u32x2 __attribute__((ext_vector_type(2)));
typedef float f32x16 __attribute__((ext_vector_type(16)));
typedef int v8i32 __attribute__((ext_vector_type(8)));

constexpr int D = 1024, NB = 8, SEQ = 4096, CTX = 256, ML = NB * SEQ, MC = NB * CTX, MT = ML + MC;
constexpr int INW = 2560, LRUW = 512, NE = 16, DE = 2816, CAP = 512, NMOD = 6;
constexpr int GU_N = 2 * DE;
constexpr float EPS = 1e-6f;
constexpr float QSCALE = 0.125f * 1.4426950408889634f;
constexpr float LAM_INIT = 0.2f;
constexpr int NWAVES = 8, NTHREADS = 512;

constexpr size_t MiB = 1u << 20;
constexpr size_t WS_CTL = 0, CTL_ZERO_BYTES = 1 * MiB;
constexpr size_t WS_MODP = 1 * MiB;
constexpr size_t WS_MOD = 3 * MiB;
constexpr size_t WS_SCAL = 3 * MiB + 512 * 1024;
constexpr size_t WS_AFF = 4 * MiB;
constexpr size_t WS_ROWID = 6 * MiB;
constexpr size_t WS_GV = 6 * MiB + 512 * 1024;
constexpr size_t WS_SLOT = 7 * MiB;
constexpr size_t WS_WIN = 10 * MiB;
constexpr size_t WS_WOUT = 15 * MiB;
constexpr size_t WS_HN = 18 * MiB;
constexpr size_t WS_MIX = 18 * MiB;
constexpr size_t WS_H2 = 18 * MiB;
constexpr size_t WS_P = 86 * MiB;
constexpr size_t WS_X1 = 86 * MiB;
constexpr size_t WS_QN = 256 * MiB;
constexpr size_t WS_KN = 272 * MiB;
constexpr size_t WS_VT = 289 * MiB;
constexpr size_t WS_WD = 306 * MiB;
constexpr size_t WS_HN8 = 350 * MiB;
constexpr size_t WS_WIN8 = 384 * MiB;
constexpr size_t WS_HH = 350 * MiB;
constexpr size_t WS_Y = 526 * MiB;
constexpr size_t WS_WGU = 590 * MiB;
constexpr size_t WS_CAGG = 694 * MiB;
constexpr size_t WS_END = 702 * MiB;
constexpr int CW_TMO = 0, CW_BAR = 4096;

constexpr int RING_BYTES = 131072;
constexpr int LDSCTL_OFF = 146432, MISC_OFF = LDSCTL_OFF + 320;
constexpr int LDS_BYTES = 147456;

#define RLX_AGENT __ATOMIC_RELAXED, __HIP_MEMORY_SCOPE_AGENT
#define LDS_WAIT() asm volatile("s_waitcnt lgkmcnt(0)" ::: "memory")
#define VM_WAIT() asm volatile("s_waitcnt vmcnt(0)" ::: "memory")
__device__ __forceinline__ unsigned f2bf(float f) { unsigned u = __builtin_bit_cast(unsigned, f); return (u + 0x7fffu + ((u >> 16) & 1u)) >> 16; }
__device__ __forceinline__ unsigned pk2(float lo, float hi) { return f2bf(lo) | (f2bf(hi) << 16); }
__device__ __forceinline__ float bflo(unsigned w) { return __builtin_bit_cast(float, w << 16); }
__device__ __forceinline__ float bfhi(unsigned w) { return __builtin_bit_cast(float, w & 0xffff0000u); }
__device__ __forceinline__ float bf2f(bf16_t h) { return __builtin_bit_cast(float, ((unsigned)h) << 16); }
__device__ __forceinline__ float wave_sum(float v) {
#pragma unroll
    for (int o = 1; o < 64; o <<= 1) v += __shfl_xor(v, o);
    return v;
}
__device__ __forceinline__ float sigmoidf_(float x) { return __builtin_amdgcn_rcpf(1.0f + __builtin_amdgcn_exp2f(-1.4426950408889634f * x)); }
__device__ __forceinline__ float siluf_(float x) { return x / (1.0f + __expf(-x)); }
__device__ __forceinline__ float gelu_tanh(float x) { const float u = 0.7978845608028654f * (x + 0.044715f * x * x * x); const float e = __builtin_amdgcn_exp2f(2.8853900817779268f * u); const float t = 1.0f - 2.0f * __builtin_amdgcn_rcpf(e + 1.0f); return 0.5f * x * (1.0f + t); }

__device__ __forceinline__ unsigned pk4_fp8(float a, float b, float c, float d) {
    a = __builtin_amdgcn_fmed3f(a, -448.f, 448.f); b = __builtin_amdgcn_fmed3f(b, -448.f, 448.f); c = __builtin_amdgcn_fmed3f(c, -448.f, 448.f); d = __builtin_amdgcn_fmed3f(d, -448.f, 448.f);
    int w = 0; w = __builtin_amdgcn_cvt_pk_fp8_f32(a, b, w, false); w = __builtin_amdgcn_cvt_pk_fp8_f32(c, d, w, true); return (unsigned)w; }
__device__ __forceinline__ unsigned pk4_fp8u(float a, float b, float c, float d) {
    int w = 0; w = __builtin_amdgcn_cvt_pk_fp8_f32(a, b, w, false); w = __builtin_amdgcn_cvt_pk_fp8_f32(c, d, w, true); return (unsigned)w; }
#define XB_TMO      128
#define XB_XCNT(j)  (256  + 64 * (j))
#define XB_XSUB(j)  (1280 + 64 * (j))
#define XB_XGEN(j)  (2304 + 64 * (j))
#define XB_TOP      3328
#define XB_TOPGEN   3392
#define XCD_BAR_WORDS 3456
#define XB_SPIN_CAP (1u << 22)
__device__ __forceinline__ unsigned xb_ld(unsigned* p)              { return __hip_atomic_load(p, __ATOMIC_RELAXED, __HIP_MEMORY_SCOPE_AGENT); }
__device__ __forceinline__ unsigned xb_add(unsigned* p, unsigned v) { return __hip_atomic_fetch_add(p, v, __ATOMIC_RELAXED, __HIP_MEMORY_SCOPE_AGENT); }
__device__ __forceinline__ unsigned xb_xcc_id() { return (unsigned)__builtin_amdgcn_s_getreg((3 << 11) | 20) & 0xFu; }
#define XB_SPIN(cond, bar) do { unsigned _sp = 0; while (cond) { __builtin_amdgcn_s_sleep(1); \
    if ((++_sp & 255u) == 0u) { if (xb_ld(&(bar)[XB_TMO])) break; if (_sp > XB_SPIN_CAP) { atomicAdd(&(bar)[XB_TMO], 1u); break; } } } } while (0)
struct XcdBarrier { unsigned* bar; unsigned x; volatile LAS unsigned* st; };
__device__ __forceinline__ XcdBarrier xcd_barrier_post(unsigned* bar, volatile LAS unsigned* st) {
    XcdBarrier b; b.bar = bar; b.x = xb_xcc_id(); b.st = st;
    if (threadIdx.x == 0) (void)xb_add(&bar[XB_XCNT(b.x)], 1u);
    return b;
}
__device__ __forceinline__ void xcd_barrier_complete(unsigned* bar, unsigned x, unsigned& nloc, unsigned& nx) {
    const unsigned G = gridDim.x * gridDim.y * gridDim.z;
    unsigned sum, cnt, mine, sp = 0u;
    for (;;) {
        sum = 0u; cnt = 0u; mine = 0u;
#pragma unroll
        for (unsigned j = 0; j < 16; ++j) { const unsigned c = xb_ld(&bar[XB_XCNT(j)]); sum += c; cnt += (c > 0u) ? 1u : 0u; mine = (j == x) ? c : mine; }
        if (sum == G) break;
        __builtin_amdgcn_s_sleep(1);
        if ((++sp & 255u) == 0u) { if (xb_ld(&bar[XB_TMO])) break; if (sp > XB_SPIN_CAP) { atomicAdd(&bar[XB_TMO], 1u); break; } }
    }
    nloc = mine > 0u ? mine : 1u; nx = cnt > 0u ? cnt : 1u;
}
__device__ __forceinline__ void xcd_barrier(const XcdBarrier& b) {
    asm volatile("s_waitcnt vmcnt(0)" ::: "memory");
    __syncthreads();
    if (threadIdx.x == 0) {
        unsigned* bar = b.bar;
        __builtin_amdgcn_s_waitcnt(0);
        unsigned nloc = b.st[0], nx = b.st[1];
        if (nloc == 0u) { xcd_barrier_complete(bar, b.x, nloc, nx); b.st[0] = nloc; b.st[1] = nx; }
        const unsigned old = xb_add(&bar[XB_XSUB(b.x)], 1u);
        const unsigned gen = old / nloc;
        if (old + 1u == (gen + 1u) * nloc) {
            __builtin_amdgcn_fence(__ATOMIC_RELEASE, "agent");
            asm volatile("s_waitcnt vmcnt(0)" ::: "memory");
            const unsigned og = xb_add(&bar[XB_TOP], 1u);
            const unsigned tg = og / nx;
            if (og + 1u == (tg + 1u) * nx) xb_add(&bar[XB_TOPGEN], 1u);
            else XB_SPIN(xb_ld(&bar[XB_TOPGEN]) == tg, bar);
            __builtin_amdgcn_fence(__ATOMIC_ACQUIRE, "agent");
            xb_add(&bar[XB_XGEN(b.x)], 1u);
            asm volatile("s_waitcnt vmcnt(0)" ::: "memory");
        } else {
            XB_SPIN(xb_ld(&bar[XB_XGEN(b.x)]) == gen, bar);
            __builtin_amdgcn_fence(__ATOMIC_ACQUIRE, "agent");
            asm volatile("s_waitcnt vmcnt(0)" ::: "memory");
        }
    }
    __syncthreads();
}

namespace pg8 {
constexpr int BM = 256, BK = 64, HALF = 128, HTB = HALF * BK * 2, STAGE_BYTES = 8 * HTB, NXCD = 8, WGM = 8;
__host__ __device__ __forceinline__ int lds_byte(int r, int c) { const int st = (r >> 4) * 2 + (c >> 5), rr = r & 15, cc = c & 31, ob = rr * 64 + cc * 2; return st * 1024 + (ob ^ (((ob >> 9) & 1) << 5)); }
__host__ __device__ __forceinline__ void stage_rc(int b, int& R, int& C) { const int st = b / 1024, sb = b % 1024, swz = sb ^ (((sb >> 9) & 1) << 5); R = (st >> 1) * 16 + swz / 64; C = (st & 1) * 32 + (swz % 64) / 2; }
__host__ __device__ __forceinline__ int perm32(int rho) { const int n = rho >> 4, i = rho & 15; return 8 * (i >> 2) + 4 * n + (i & 3); }

__device__ __forceinline__ float xhalf32(float x, int hi) {
    const unsigned uu = __builtin_bit_cast(unsigned, x); const auto rr = __builtin_amdgcn_permlane32_swap(uu, uu, false, false);
    return __builtin_bit_cast(float, hi ? rr[0] : rr[1]); }
struct Unit { int pm, pn, pb; };
struct StaticOrder {
    int nM, nN, nwg, G, c, bgrp, bmul;
    __device__ void init(int M, int N, int G_, int c_, int bgrp_ = 1 << 30, int bmul_ = 0) { nM = M / BM; nN = N / BM; nwg = nM * nN; G = G_; c = c_; bgrp = bgrp_; bmul = bmul_; }
    __device__ bool next(int i, Unit& u) const {
        const long L = (long)i * G + c; if (L >= nwg) return false;
        int wgid = (int)L; { const int q = nwg / NXCD, r = nwg % NXCD, xcd = wgid % NXCD, off = wgid / NXCD; wgid = (xcd < r ? xcd * (q + 1) : r * (q + 1) + (xcd - r) * q) + off; }
        const int nig = WGM * nN, gid = wgid / nig, fm = gid * WGM, gsz = (nM - fm) < WGM ? (nM - fm) : WGM;
        u.pm = fm + ((wgid % nig) % gsz); u.pn = (wgid % nig) / gsz; u.pb = (u.pm / bgrp) * bmul + u.pn; return true;
    }
};
struct InProjOrderA {
    StaticOrder lat; int G, c;
    __device__ void init(int G_, int c_) { lat.init(ML, 1024, G_, c_); G = G_; c = c_; }
    __device__ bool next(int i, Unit& u) const {
        const int L = i * G + c;
        if (L < 512) return lat.next(i, u);
        const int j = L - 512; if (j >= 16) return false;
        u.pm = 128 + (j >> 1); u.pn = j & 1; u.pb = u.pn; return true;
    }
};
struct InProjOrderB {
    StaticOrder lat; int G, c;
    __device__ void init(int G_, int c_) { lat.init(ML, 1536, G_, c_); G = G_; c = c_; }
    __device__ bool next(int i, Unit& u) const {
        const int L = i * G + c;
        if (L < 768) { if (!lat.next(i, u)) return false; u.pb = u.pn; u.pn += 4; return true; }
        int j = L - 768; if (G == 256) j -= 16;
        if (j < 0 || j >= 32) return false;
        u.pm = 128 + (j >> 2); u.pn = 6 + (j & 3); u.pb = u.pn - 4; return true;
    }
};
__device__ __forceinline__ unsigned cvt_pk_bf16(float lo, float hi) { unsigned r; asm volatile("v_cvt_pk_bf16_f32 %0, %1, %2" : "=v"(r) : "v"(lo), "v"(hi)); return r; }

struct EpiBf16 {
    static constexpr bool PERM = true;
    bf16_t* O; int ldc;
    __device__ __forceinline__ void operator()(const f32x4 (&acc)[2][2][4][2], const Unit& u, int wr, int wc, int fr, int fq) const {
        const int row0 = u.pm * BM + wr * 64 + fr; const int col0 = u.pn * BM + wc * 32 + 8 * fq;
#pragma unroll
        for (int ai = 0; ai < 2; ++ai)
#pragma unroll
            for (int m = 0; m < 4; ++m) { bf16_t* rowp = O + (size_t)(row0 + ai * HALF + m * 16) * ldc + col0;
#pragma unroll
                for (int bj = 0; bj < 2; ++bj) { const f32x4 v0 = acc[ai][bj][m][0], v1 = acc[ai][bj][m][1];
                    u32x4 w; w.x = cvt_pk_bf16(v0[0], v0[1]); w.y = cvt_pk_bf16(v0[2], v0[3]); w.z = cvt_pk_bf16(v1[0], v1[1]); w.w = cvt_pk_bf16(v1[2], v1[3]);
                    *(u32x4*)(rowp + bj * HALF) = w; } }
    }
};
template <bool F8> struct EpiInProj {
    static constexpr bool PERM = true; static constexpr float pre = F8 ? (1.0f / 32.0f) : 1.0f;
    bf16_t* PB; unsigned char* QN8; unsigned char* KN8; const float* rope; const float* qg; const float* kg; LAS float* xs;
    __device__ __forceinline__ void operator()(const f32x4 (&acc)[2][2][4][2], const Unit& u, int wr, int wc, int fr, int fq) const {
        const int row0 = u.pm * BM + wr * 64 + fr;
        if (!F8 || u.pn >= 8) {
            const int col0 = u.pn * BM + wc * 32 + 8 * fq;
#pragma unroll
            for (int ai = 0; ai < 2; ++ai)
#pragma unroll
                for (int m = 0; m < 4; ++m) { bf16_t* rowp = PB + (size_t)(row0 + ai * HALF + m * 16) * INW + col0;
#pragma unroll
                    for (int bj = 0; bj < 2; ++bj) { const f32x4 v0 = acc[ai][bj][m][0] * pre, v1 = acc[ai][bj][m][1] * pre;
                        u32x4 w; w.x = cvt_pk_bf16(v0[0], v0[1]); w.y = cvt_pk_bf16(v0[2], v0[3]); w.z = cvt_pk_bf16(v1[0], v1[1]); w.w = cvt_pk_bf16(v1[2], v1[3]);
                        *(u32x4*)(rowp + bj * HALF) = w; } }
            return;
        }
        if constexpr (F8) {
        const bool isq = u.pn < 6, lat = u.pm < (ML / BM);
        const int wave = wr * 4 + wc, axis = wc & 1; const bool x2half = fq >= 2; const int p0 = 8 * (fq & 1);
        LAS float* xw = xs + (wave * 256 + fr), * xp = xs + ((wave ^ 1) * 256 + fr);
        asm volatile("" : "+v"(xw), "+v"(xp));
#pragma unroll
        for (int ai = 0; ai < 2; ++ai)
#pragma unroll
            for (int bj = 0; bj < 2; ++bj)
#pragma unroll
                for (int m = 0; m < 4; ++m) { const f32x4 a0 = acc[ai][bj][m][0], a1 = acc[ai][bj][m][1];
                    float p = (a0[0] * a0[0] + a0[1] * a0[1]) + (a0[2] * a0[2] + a0[3] * a0[3]) + (a1[0] * a1[0] + a1[1] * a1[1]) + (a1[2] * a1[2] + a1[3] * a1[3]);
                    p += __shfl_xor(p, 16); p += __shfl_xor(p, 32);
                    if (fq == 0) xw[(ai * 8 + bj * 4 + m) * 16] = p; }
        asm volatile("s_waitcnt lgkmcnt(0)" ::: "memory"); __builtin_amdgcn_s_barrier(); asm volatile("" ::: "memory");
        f32x4 g0, g1;
        { const float* gp = (isq ? qg : kg) + 32 * axis + 8 * fq; g0 = *(const f32x4*)gp; g1 = *(const f32x4*)(gp + 4); if (isq) { g0 = g0 * QSCALE; g1 = g1 * QSCALE; } }
#pragma unroll
        for (int ai = 0; ai < 2; ++ai)
#pragma unroll
            for (int m = 0; m < 4; ++m) {
                const int row = row0 + ai * HALF + m * 16; const int b = lat ? (row >> 12) : ((row - ML) >> 8); const int t = lat ? (row & 4095) : ((row - ML) & 255);
                f32x4 c0 = (f32x4){1.f, 1.f, 1.f, 1.f}, c1 = c0, s0 = (f32x4){0.f, 0.f, 0.f, 0.f}, s1 = s0;
                if (lat) { const int pos = axis ? (t & 63) : (t >> 6); const float* rp = rope + pos * 16 + p0;
                    c0 = *(const f32x4*)rp; c1 = *(const f32x4*)(rp + 4); s0 = *(const f32x4*)(rp + 1024); s1 = *(const f32x4*)(rp + 1028); if (!x2half) { s0 = -s0; s1 = -s1; } }
#pragma unroll
                for (int bj = 0; bj < 2; ++bj) {
                    const float tot = xw[(ai * 8 + bj * 4 + m) * 16] + xp[(ai * 8 + bj * 4 + m) * 16];
                    const float rstd = pre * __builtin_amdgcn_rsqf(tot * (pre * pre * (1.0f / 64.0f)) + EPS);
                    const f32x4 v0 = acc[ai][bj][m][0] * rstd * g0, v1 = acc[ai][bj][m][1] * rstd * g1;
                    float o[8];
#pragma unroll
                    for (int i = 0; i < 4; ++i) { o[i] = v0[i] * c0[i] + xhalf32(v0[i], fq >> 1) * s0[i]; o[4 + i] = v1[i] * c1[i] + xhalf32(v1[i], fq >> 1) * s1[i]; }
                    const int gc = (u.pn & 1) * 4 + 2 * bj + (wc >> 1); const int h = gc >> 1, c = gc & 1;
                    const unsigned doff = isq ? (unsigned)(((b * 4 + h) * SEQ + t) * 128 + c * 64 + 32 * axis + 8 * fq) : (unsigned)(((b * 4 + h) * 4352 + (lat ? CTX + t : t)) * 128 + c * 64 + 32 * axis + 8 * fq);
                    u32x2 ov; ov.x = pk4_fp8u(o[0], o[1], o[2], o[3]); ov.y = pk4_fp8u(o[4], o[5], o[6], o[7]);
                    *(u32x2*)((isq ? QN8 : KN8) + doff) = ov;
                    asm volatile("" ::: "memory"); }
                asm volatile("" ::: "memory");
            }
        }
    }
};
struct EpiResid {
    static constexpr bool PERM = true;
    const float* x; bf16_t* out; const float* mod;
    int gch;
    __device__ __forceinline__ void operator()(const f32x4 (&acc)[2][2][4][2], const Unit& u, int wr, int wc, int fr, int fq) const {
        const int row0 = u.pm * BM + wr * 64 + fr, col0 = u.pn * BM + wc * 32 + 8 * fq; const int b = u.pm >> 4;
        f32x4 gv[2][2];
#pragma unroll
        for (int bj = 0; bj < 2; ++bj)
#pragma unroll
            for (int n = 0; n < 2; ++n) gv[bj][n] = *(const f32x4*)(mod + (size_t)b * (NMOD * D) + gch * D + col0 + bj * HALF + n * 4);
#pragma unroll
        for (int ai = 0; ai < 2; ++ai)
#pragma unroll
            for (int m = 0; m < 4; ++m) { const size_t off = (size_t)(row0 + ai * HALF + m * 16) * D + col0;
#pragma unroll
                for (int bj = 0; bj < 2; ++bj) { const f32x4 x0 = *(const f32x4*)(x + off + bj * HALF), x1 = *(const f32x4*)(x + off + bj * HALF + 4);
                    const f32x4 v0 = x0 + gv[bj][0] * acc[ai][bj][m][0], v1 = x1 + gv[bj][1] * acc[ai][bj][m][1];
                    u32x4 w; w.x = cvt_pk_bf16(v0[0], v0[1]); w.y = cvt_pk_bf16(v0[2], v0[3]); w.z = cvt_pk_bf16(v1[0], v1[1]); w.w = cvt_pk_bf16(v1[2], v1[3]);
                    *(u32x4*)(out + off + bj * HALF) = w; }
                asm volatile("" ::: "memory"); }
    }
};
struct EpiSwiGLU {
    static constexpr bool PERM = true;
    bf16_t* H;
    __device__ __forceinline__ void operator()(const f32x4 (&acc)[2][2][4][2], const Unit& u, int wr, int wc, int fr, int fq) const {
        const int row0 = u.pm * BM + wr * 64 + fr; const int col0 = u.pn * HALF + wc * 32 + 8 * fq;
#pragma unroll
        for (int ai = 0; ai < 2; ++ai)
#pragma unroll
            for (int m = 0; m < 4; ++m) { bf16_t* rowp = H + (size_t)(row0 + ai * HALF + m * 16) * DE + col0;
                f32x4 h0, h1;
#pragma unroll
                for (int j = 0; j < 4; ++j) { const float g0 = acc[ai][0][m][0][j], g1 = acc[ai][0][m][1][j];
                    h0[j] = g0 * __builtin_amdgcn_rcpf(1.0f + __builtin_amdgcn_exp2f(-1.4426950408889634f * g0)) * acc[ai][1][m][0][j];
                    h1[j] = g1 * __builtin_amdgcn_rcpf(1.0f + __builtin_amdgcn_exp2f(-1.4426950408889634f * g1)) * acc[ai][1][m][1][j]; }
                u32x4 w; w.x = cvt_pk_bf16(h0[0], h0[1]); w.y = cvt_pk_bf16(h0[2], h0[3]); w.z = cvt_pk_bf16(h1[0], h1[1]); w.w = cvt_pk_bf16(h1[2], h1[3]);
                *(u32x4*)rowp = w; }
    }
};
struct EpiSwiGLU8 {
    static constexpr bool PERM = true;
    unsigned char* H;
    __device__ __forceinline__ void operator()(const f32x4 (&acc)[2][2][4][2], const Unit& u, int wr, int wc, int fr, int fq) const {
        const int row0 = u.pm * BM + wr * 64 + fr; const int col0 = u.pn * HALF + wc * 32 + 8 * fq;
#pragma unroll
        for (int ai = 0; ai < 2; ++ai)
#pragma unroll
            for (int m = 0; m < 4; ++m) { unsigned char* rowp = H + (size_t)(row0 + ai * HALF + m * 16) * DE + col0;
                f32x4 h0, h1;
#pragma unroll
                for (int j = 0; j < 4; ++j) { const float g0 = acc[ai][0][m][0][j], g1 = acc[ai][0][m][1][j];
                    h0[j] = (1.0f / 256.0f) * g0 * __builtin_amdgcn_rcpf(1.0f + __builtin_amdgcn_exp2f((-1.4426950408889634f / 32.0f) * g0)) * acc[ai][1][m][0][j];
                    h1[j] = (1.0f / 256.0f) * g1 * __builtin_amdgcn_rcpf(1.0f + __builtin_amdgcn_exp2f((-1.4426950408889634f / 32.0f) * g1)) * acc[ai][1][m][1][j]; }
                u32x2 w; w.x = pk4_fp8(h0[0], h0[1], h0[2], h0[3]); w.y = pk4_fp8(h1[0], h1[1], h1[2], h1[3]);
                *(u32x2*)rowp = w; }
    }
};
struct EpiScaleBf16 {
    static constexpr bool PERM = true;
    unsigned char* Y; const float* gv; float mul;
    __device__ __forceinline__ void operator()(const f32x4 (&acc)[2][2][4][2], const Unit& u, int wr, int wc, int fr, int fq) const {
        const int row0 = u.pm * BM + wr * 64 + fr; const int col0 = u.pn * BM + wc * 32 + 8 * fq;
#pragma unroll
        for (int ai = 0; ai < 2; ++ai)
#pragma unroll
            for (int m = 0; m < 4; ++m) { const int row = row0 + ai * HALF + m * 16; const float s = gv[row] * mul; unsigned char* rowp = Y + (size_t)row * D + col0;
#pragma unroll
                for (int bj = 0; bj < 2; ++bj) { const f32x4 v0 = acc[ai][bj][m][0] * s, v1 = acc[ai][bj][m][1] * s;
                    u32x2 w; w.x = pk4_fp8(v0[0], v0[1], v0[2], v0[3]); w.y = pk4_fp8(v1[0], v1[1], v1[2], v1[3]);
                    *(u32x2*)(rowp + bj * HALF) = w; } }
    }
};


template <class Epi, class Sched, bool GATHER, int EB = 2, bool ALIGN_EPI = true, bool SP2 = true>
__device__ __forceinline__ void gemm_phase(LAS unsigned char* lds, const void* A, const void* Bt, const int Kel, const int* rowid, const Sched& S, const Epi& E) {
    const int K = Kel * EB / 2;
    const int nt = K / BK;
    const int tid = threadIdx.x, wid = __builtin_amdgcn_readfirstlane(tid >> 6), lane = tid & 63, wr = wid >> 2, wc = wid & 3, fr = lane & 15, fq = lane >> 4;
    unsigned voffB[2], cvA[2][2];
#pragma unroll
    for (int i = 0; i < 2; ++i) { int Rr, Cc; stage_rc(tid * 16 + i * 8192, Rr, Cc); const int Rb = Epi::PERM ? ((Rr & ~31) + perm32(Rr & 31)) : Rr;
        voffB[i] = (unsigned)(Rb * K + Cc) * 2u; }
    const size_t kstep = (size_t)(BK * 2);
    const size_t hstep = (size_t)HALF * K * 2;
    const size_t tstep = 2 * hstep;
    const unsigned ldsw = (unsigned)wid * 1024u;
    int aoffk[2], boffk[2];
    aoffk[0] = lds_byte(wr * 64 + fr, fq * 8); aoffk[1] = aoffk[0] + 1024; boffk[0] = lds_byte(wc * 32 + fr, fq * 8); boffk[1] = boffk[0] + 1024;
#define PG8_SA(b, h) (((b) * 2 + (h)) * HTB)
#define PG8_SB(b, h) ((4 + (b) * 2 + (h)) * HTB)
#define PG8_STAGE(bufoff, gbase, voff) do { _Pragma("unroll") for (int _i = 0; _i < 2; ++_i) \
        __builtin_amdgcn_global_load_lds((const unsigned*)((const char*)(gbase) + (voff)[_i]), (LAS unsigned*)(lds + (bufoff) + ldsw + _i * 8192), 16, 0, 0); } while (0)
#define PG8_LDA(dst, b, h) do { _Pragma("unroll") for (int m = 0; m < 4; ++m) _Pragma("unroll") for (int k = 0; k < 2; ++k) dst[m][k] = *(const LAS u32x4*)(lds + PG8_SA(b, h) + aoffk[k] + m * 2048); } while (0)
#define PG8_LDB(dst, b, h) do { _Pragma("unroll") for (int n = 0; n < 2; ++n) _Pragma("unroll") for (int k = 0; k < 2; ++k) dst[n][k] = *(const LAS u32x4*)(lds + PG8_SB(b, h) + boffk[k] + n * 2048); } while (0)
#define PG8_MMA(ai, bj, At, Bt_) do { __builtin_amdgcn_s_setprio(1); _Pragma("unroll") for (int m = 0; m < 4; ++m) _Pragma("unroll") for (int n = 0; n < 2; ++n) { \
        if (EB == 2) { _Pragma("unroll") for (int k = 0; k < 2; ++k) acc[ai][bj][m][n] = __builtin_amdgcn_mfma_f32_16x16x32_bf16(__builtin_bit_cast(bf16x8, Bt_[n][k]), __builtin_bit_cast(bf16x8, At[m][k]), acc[ai][bj][m][n], 0, 0, 0); } \
        else { const v8i32 _b = __builtin_bit_cast(v8i32, __builtin_shufflevector(Bt_[n][0], Bt_[n][1], 0, 1, 2, 3, 4, 5, 6, 7)); \
               const v8i32 _a = __builtin_bit_cast(v8i32, __builtin_shufflevector(At[m][0], At[m][1], 0, 1, 2, 3, 4, 5, 6, 7)); \
               acc[ai][bj][m][n] = __builtin_amdgcn_mfma_scale_f32_16x16x128_f8f6f4(_b, _a, acc[ai][bj][m][n], 0, 0, 0, 0, 0, 0); } } \
        __builtin_amdgcn_s_setprio(0); } while (0)
#define PG8_WAIT_V(n) asm volatile("s_waitcnt vmcnt(" #n ")" ::: "memory")
#define PG8_WAIT_L(n) asm volatile("s_waitcnt lgkmcnt(" #n ")" ::: "memory")
#define PG8_BAR __builtin_amdgcn_s_barrier()
#define PG8_SCHED __builtin_amdgcn_sched_barrier(0)
#define PG8_AOFFS(dst, u) do { _Pragma("unroll") for (int _h = 0; _h < 2; ++_h) _Pragma("unroll") for (int _i = 0; _i < 2; ++_i) { int _R, _C; stage_rc(tid * 16 + _i * 8192, _R, _C); \
        if (GATHER) dst[_h][_i] = (unsigned)rowid[(u).pm * BM + _h * HALF + _R] * (unsigned)(K * 2) + (unsigned)_C * 2u; \
        else dst[_h][_i] = (unsigned)(((u).pm * BM + _h * HALF + _R) * K + _C) * 2u; } } while (0)
    Unit cur, nxt; int ui = 0;
    if (!S.next(0, cur)) return;
    f32x4 acc[2][2][4][2];
#pragma unroll
    for (int a = 0; a < 2; ++a)
#pragma unroll
        for (int b = 0; b < 2; ++b)
#pragma unroll
            for (int m = 0; m < 4; ++m)
#pragma unroll
                for (int n = 0; n < 2; ++n) acc[a][b][m][n] = (f32x4){0.f, 0.f, 0.f, 0.f};
    u32x4 At[4][2], B0[2][2], B1[2][2];
    const char* cA = (const char*)A; const char* cB = (const char*)Bt + (size_t)cur.pb * tstep;
    PG8_AOFFS(cvA, cur);
    if constexpr (SP2) {
        PG8_STAGE(PG8_SB(0, 0), cB, voffB); PG8_STAGE(PG8_SB(0, 1), cB + hstep, voffB); PG8_STAGE(PG8_SA(0, 0), cA, cvA[0]); PG8_STAGE(PG8_SA(0, 1), cA, cvA[1]);
        if (wr == 1) PG8_BAR;
        PG8_WAIT_V(2); PG8_BAR;
        PG8_STAGE(PG8_SB(1, 0), cB + kstep, voffB); PG8_STAGE(PG8_SA(1, 0), cA + kstep, cvA[0]); PG8_STAGE(PG8_SB(1, 1), cB + hstep + kstep, voffB);
        PG8_WAIT_V(6); PG8_BAR;
    } else {
        PG8_STAGE(PG8_SB(0, 0), cB, voffB); PG8_STAGE(PG8_SA(0, 0), cA, cvA[0]); PG8_STAGE(PG8_SB(0, 1), cB + hstep, voffB); PG8_STAGE(PG8_SA(0, 1), cA, cvA[1]);
        if (wr == 1) PG8_BAR;
        PG8_WAIT_V(4); PG8_BAR;
        PG8_STAGE(PG8_SB(1, 0), cB + kstep, voffB); PG8_STAGE(PG8_SA(1, 0), cA + kstep, cvA[0]); PG8_STAGE(PG8_SB(1, 1), cB + hstep + kstep, voffB);
        PG8_WAIT_V(6); PG8_BAR;
    }
    for (;;) {
        const bool has_next = S.next(ui + 1, nxt);
        const char* nA = cA; const char* nB = has_next ? (const char*)Bt + (size_t)nxt.pb * tstep : cB;
        for (int t = 0; t < nt; t += 2) {
            const bool last = (t == nt - 2);
            asm volatile("" : "+v"(cvA[0][0]), "+v"(cvA[0][1]), "+v"(cvA[1][0]), "+v"(cvA[1][1]), "+v"(voffB[0]), "+v"(voffB[1]));
            const char* a1 = cA + (size_t)(t + 1) * kstep;
            const char* a2 = last ? nA : cA + (size_t)(t + 2) * kstep; const char* b2 = last ? nB : cB + (size_t)(t + 2) * kstep;
            const char* a3 = a2 + kstep; const char* b3 = b2 + kstep;
            if constexpr (SP2) {
            PG8_LDB(B0, 0, 0); PG8_LDB(B1, 0, 1); PG8_SCHED; PG8_LDA(At, 0, 0); PG8_STAGE(PG8_SA(1, 1), a1, cvA[1]);
            if (last && has_next) { PG8_AOFFS(cvA, nxt); }
            PG8_WAIT_V(8); PG8_WAIT_L(0); PG8_BAR; PG8_MMA(0, 0, At, B0); PG8_MMA(0, 1, At, B1); PG8_BAR; PG8_SCHED;
            PG8_LDA(At, 0, 1); PG8_STAGE(PG8_SB(0, 0), b2, voffB); PG8_STAGE(PG8_SB(0, 1), b2 + hstep, voffB); PG8_STAGE(PG8_SA(0, 0), a2, cvA[0]);
            PG8_WAIT_V(8); PG8_WAIT_L(0); PG8_BAR; PG8_MMA(1, 0, At, B0); PG8_MMA(1, 1, At, B1); PG8_BAR; PG8_SCHED;
            PG8_LDB(B0, 1, 0); PG8_LDB(B1, 1, 1); PG8_SCHED; PG8_LDA(At, 1, 0); PG8_STAGE(PG8_SA(0, 1), a2, cvA[1]);
            PG8_WAIT_V(8); PG8_WAIT_L(0); PG8_BAR; PG8_MMA(0, 0, At, B0); PG8_MMA(0, 1, At, B1); PG8_BAR; PG8_SCHED;
            PG8_LDA(At, 1, 1); PG8_STAGE(PG8_SB(1, 0), b3, voffB); PG8_STAGE(PG8_SB(1, 1), b3 + hstep, voffB); PG8_STAGE(PG8_SA(1, 0), a3, cvA[0]);
            PG8_WAIT_V(8); PG8_WAIT_L(0); PG8_BAR; PG8_MMA(1, 0, At, B0); PG8_MMA(1, 1, At, B1); PG8_BAR; PG8_SCHED;
            } else {
            PG8_LDB(B0, 0, 0); PG8_SCHED; PG8_LDA(At, 0, 0); PG8_STAGE(PG8_SA(1, 1), a1, cvA[1]);
            if (last && has_next) { PG8_AOFFS(cvA, nxt); }
            PG8_WAIT_L(8); PG8_BAR; PG8_WAIT_L(0); PG8_MMA(0, 0, At, B0); PG8_BAR; PG8_SCHED;
            PG8_LDB(B1, 0, 1); PG8_STAGE(PG8_SB(0, 0), b2, voffB);
            PG8_BAR; PG8_WAIT_L(0); PG8_MMA(0, 1, At, B1); PG8_BAR;
            PG8_LDA(At, 0, 1); PG8_STAGE(PG8_SA(0, 0), a2, cvA[0]);
            PG8_BAR; PG8_WAIT_L(0); PG8_MMA(1, 0, At, B0); PG8_BAR; PG8_SCHED;
            PG8_STAGE(PG8_SB(0, 1), b2 + hstep, voffB);
            PG8_WAIT_V(6); PG8_BAR; PG8_MMA(1, 1, At, B1); PG8_BAR;
            PG8_LDB(B0, 1, 0); PG8_SCHED; PG8_LDA(At, 1, 0); PG8_STAGE(PG8_SA(0, 1), a2, cvA[1]);
            PG8_WAIT_L(8); PG8_BAR; PG8_WAIT_L(0); PG8_MMA(0, 0, At, B0); PG8_BAR; PG8_SCHED;
            PG8_LDB(B1, 1, 1); PG8_STAGE(PG8_SB(1, 0), b3, voffB);
            PG8_BAR; PG8_WAIT_L(0); PG8_MMA(0, 1, At, B1); PG8_BAR;
            PG8_LDA(At, 1, 1); PG8_STAGE(PG8_SA(1, 0), a3, cvA[0]);
            PG8_BAR; PG8_WAIT_L(0); PG8_MMA(1, 0, At, B0); PG8_BAR; PG8_SCHED;
            PG8_STAGE(PG8_SB(1, 1), b3 + hstep, voffB);
            PG8_WAIT_V(6); PG8_BAR; PG8_MMA(1, 1, At, B1); PG8_BAR;
            }
        }
        if constexpr (ALIGN_EPI) { if (wr == 0) PG8_BAR; }
        E(acc, cur, wr, wc, fr, fq);
        if (!has_next) break;
#pragma unroll
        for (int a = 0; a < 2; ++a)
#pragma unroll
            for (int b = 0; b < 2; ++b)
#pragma unroll
                for (int m = 0; m < 4; ++m)
#pragma unroll
                    for (int n = 0; n < 2; ++n) acc[a][b][m][n] = (f32x4){0.f, 0.f, 0.f, 0.f};
        cur = nxt; cA = nA; cB = nB; ++ui;
        if constexpr (ALIGN_EPI) { if (wr == 1) PG8_BAR; }
    }
    PG8_WAIT_V(0);
    if constexpr (!ALIGN_EPI) { if (wr == 0) PG8_BAR; }
    PG8_BAR;
#undef PG8_SA
#undef PG8_SB
#undef PG8_STAGE
#undef PG8_LDA
#undef PG8_LDB
#undef PG8_MMA
#undef PG8_WAIT_V
#undef PG8_WAIT_L
#undef PG8_BAR
#undef PG8_SCHED
#undef PG8_AOFFS
}
}


#define CROW(r, hh) (((r) & 3) + 8 * ((r) >> 2) + 4 * (hh))
__device__ __forceinline__ float xhalf(float x, int hh) {
    const unsigned u = __builtin_bit_cast(unsigned, x); const auto rr = __builtin_amdgcn_permlane32_swap(u, u, false, false);
    return __builtin_bit_cast(float, hh ? rr[0] : rr[1]); }
template <int PASS>
__device__ __forceinline__ void lru_item(const LAS unsigned char* WL, LAS unsigned char* xct, const bf16_t* PB, bf16_t* MIX, f32x2* CAGG,
        const float* convw, const float* convb, const float* ba, const float* bi, const float* lamp, const int n, const int b, const int chunk, const int lane, const float hc0, const float hc1) {
    const int r32 = lane & 31, hh = lane >> 5;
    const bool isctx = chunk < 4; const int t0 = isctx ? chunk * 64 : (chunk - 4) * 64; const int L = isctx ? CTX : SEQ;
    const size_t rowbase = isctx ? (size_t)(ML + b * CTX) : (size_t)(b * SEQ);
    {
        const int c8 = lane & 7, rg = lane >> 3; const int ch = n * 64 + 8 * c8;
        const bf16_t* xp = PB + rowbase * INW + ch; const int tb0 = t0 + 8 * rg - 1;
        u32x4 raw[11];
#pragma unroll
        for (int i = 0; i < 11; ++i) { const int tt = tb0 + i; raw[i] = (tt >= 0 && tt < L) ? *(const u32x4*)(xp + (size_t)tt * INW) : (u32x4){0u, 0u, 0u, 0u}; }
        f32x4 wlo[4], whi[4];
#pragma unroll
        for (int k = 0; k < 4; ++k) { wlo[k] = *(const f32x4*)(convw + k * 512 + ch); whi[k] = *(const f32x4*)(convw + k * 512 + ch + 4); }
        const f32x4 blo = *(const f32x4*)(convb + ch), bhi = *(const f32x4*)(convb + ch + 4);
#pragma unroll
        for (int tk = 0; tk < 8; ++tk) {
            f32x4 ylo = blo, yhi = bhi;
#pragma unroll
            for (int k = 0; k < 4; ++k) { const u32x4 rw = raw[tk + k];
                ylo += wlo[k] * (f32x4){bflo(rw.x), bfhi(rw.x), bflo(rw.y), bfhi(rw.y)}; yhi += whi[k] * (f32x4){bflo(rw.z), bfhi(rw.z), bflo(rw.w), bfhi(rw.w)}; }
            u32x4 o; o.x = pk2(ylo.x, ylo.y); o.y = pk2(ylo.z, ylo.w); o.z = pk2(yhi.x, yhi.y); o.w = pk2(yhi.z, yhi.w);
            *(LAS u32x4*)(xct + (8 * rg + tk) * 144 + c8 * 16) = o; }
    }
    LDS_WAIT(); asm volatile("" ::: "memory");
    bf16x8 af[2][4];
#pragma unroll
    for (int tb = 0; tb < 2; ++tb)
#pragma unroll
        for (int ks = 0; ks < 4; ++ks) af[tb][ks] = *(const LAS bf16x8*)(xct + (32 * tb + r32) * 144 + ks * 32 + hh * 16);
#pragma unroll 1
    for (int vb = 0; vb < 2; ++vb) {
        const int ch = n * 64 + 32 * vb + r32;
        float hsum[2][16];
#pragma unroll
        for (int d = 0; d < 2; ++d) {
            f32x16 ga[2], gi[2];
#pragma unroll
            for (int tb = 0; tb < 2; ++tb)
#pragma unroll
                for (int r = 0; r < 16; ++r) { ga[tb][r] = 0.f; gi[tb][r] = 0.f; }
#pragma unroll
            for (int ks = 0; ks < 4; ++ks) {
                const bf16x8 wa = *(const LAS bf16x8*)(WL + ((2 * d) * 64 + 32 * vb + r32) * 144 + ks * 32 + hh * 16);
                const bf16x8 wi = *(const LAS bf16x8*)(WL + ((2 * d + 1) * 64 + 32 * vb + r32) * 144 + ks * 32 + hh * 16);
#pragma unroll
                for (int tb = 0; tb < 2; ++tb) { ga[tb] = __builtin_amdgcn_mfma_f32_32x32x16_bf16(af[tb][ks], wa, ga[tb], 0, 0, 0); gi[tb] = __builtin_amdgcn_mfma_f32_32x32x16_bf16(af[tb][ks], wi, gi[tb], 0, 0, 0); }
            }
            const float nba = -1.4426950408889634f * ba[d * 512 + ch], nbi = -1.4426950408889634f * bi[d * 512 + ch]; const float sp8l = -8.0f * 1.4426950408889634f * log1pf(__expf(-lamp[d * 512 + ch]));
            const bool has_reset = isctx && (d == 0 ? (chunk == 0) : (chunk == 3));
#pragma unroll
            for (int tb = 0; tb < 2; ++tb)
#pragma unroll
                for (int r = 0; r < 16; ++r) { const int tl = 32 * tb + CROW(r, hh);
                    const float xcv = bf2f(*(const LAS bf16_t*)(xct + tl * 144 + (32 * vb + r32) * 2));
                    const float rr = __builtin_amdgcn_rcpf(1.0f + __builtin_amdgcn_exp2f(__builtin_fmaf(ga[tb][r], -1.4426950408889634f, nba)));
                    const float ii = __builtin_amdgcn_rcpf(1.0f + __builtin_amdgcn_exp2f(__builtin_fmaf(gi[tb][r], -1.4426950408889634f, nbi)));
                    const float a = __builtin_amdgcn_exp2f(rr * sp8l);
                    float mult = __builtin_amdgcn_sqrtf(fmaxf(__builtin_fmaf(-a, a, 1.0f), 0.f));
                    if ((d == 0 && tb == 0 && r == 0) || (d == 1 && tb == 1 && r == 15)) { if (has_reset && hh == d) mult = 1.0f; }
                    ga[tb][r] = a; gi[tb][r] = mult * (ii * xcv); }
#pragma unroll
            for (int tb = 0; tb < 2; ++tb)
#pragma unroll
                for (int g = 0; g < 4; ++g) {
                    if (d == 0) {
#pragma unroll
                        for (int i = 1; i < 4; ++i) { gi[tb][4 * g + i] = ga[tb][4 * g + i] * gi[tb][4 * g + i - 1] + gi[tb][4 * g + i]; ga[tb][4 * g + i] *= ga[tb][4 * g + i - 1]; }
                    } else {
#pragma unroll
                        for (int i = 2; i >= 0; --i) { gi[tb][4 * g + i] = ga[tb][4 * g + i] * gi[tb][4 * g + i + 1] + gi[tb][4 * g + i]; ga[tb][4 * g + i] *= ga[tb][4 * g + i + 1]; }
                    }
                }
            const int e4 = (d == 0) ? 3 : 0;
            float A0[8], U0[8], A1[8], U1[8];
#pragma unroll
            for (int q = 0; q < 8; ++q) { const float mA = ga[q >> 2][4 * (q & 3) + e4], mU = gi[q >> 2][4 * (q & 3) + e4];
                const float pA = xhalf(mA, hh), pU = xhalf(mU, hh);
                A0[q] = hh ? pA : mA; U0[q] = hh ? pU : mU; A1[q] = hh ? mA : pA; U1[q] = hh ? mU : pU; }
            float hin[8];
            if (PASS == 0) {
                float Ast = 1.0f, Ust = 0.0f;
#pragma unroll
                for (int qq = 0; qq < 8; ++qq) { const int q = (d == 0) ? qq : 7 - qq;
                    if (d == 0) { Ust = A0[q] * Ust + U0[q]; Ast *= A0[q]; Ust = A1[q] * Ust + U1[q]; Ast *= A1[q]; }
                    else        { Ust = A1[q] * Ust + U1[q]; Ast *= A1[q]; Ust = A0[q] * Ust + U0[q]; Ast *= A0[q]; } }
                if (hh == 0) CAGG[((size_t)(b * 68 + chunk) * 2 + d) * 512 + ch] = (f32x2){Ast, Ust};
            } else {
                float hst = __shfl(d == 0 ? hc0 : hc1, 32 * vb + r32);
#pragma unroll
                for (int qq = 0; qq < 8; ++qq) { const int q = (d == 0) ? qq : 7 - qq;
                    if (d == 0) { const float mid = A0[q] * hst + U0[q]; hin[q] = hh ? mid : hst; hst = A1[q] * mid + U1[q]; }
                    else        { const float mid = A1[q] * hst + U1[q]; hin[q] = hh ? hst : mid; hst = A0[q] * mid + U0[q]; } }
#pragma unroll
                for (int tb = 0; tb < 2; ++tb)
#pragma unroll
                    for (int r = 0; r < 16; ++r) { const float hv = ga[tb][r] * hin[tb * 4 + (r >> 2)] + gi[tb][r]; hsum[tb][r] = (d == 0) ? hv : hsum[tb][r] + hv; }
            }
        }
        if (PASS == 1) {
#pragma unroll
            for (int tb = 0; tb < 2; ++tb)
#pragma unroll
                for (int r = 0; r < 16; ++r) *(LAS bf16_t*)(xct + (32 * tb + CROW(r, hh)) * 144 + (32 * vb + r32) * 2) = (bf16_t)f2bf(hsum[tb][r]);
        }
    }
    if (PASS == 1) {
        LDS_WAIT(); asm volatile("" ::: "memory");
        const int rr0 = lane >> 3, cg = lane & 7;
#pragma unroll 2
        for (int it = 0; it < 8; ++it) { const int tl = it * 8 + rr0; const size_t row = rowbase + t0 + tl;
            const u32x4 hv = *(const LAS u32x4*)(xct + tl * 144 + cg * 16); const u32x4 gv = *(const u32x4*)(PB + row * INW + 512 + n * 64 + cg * 8);
            u32x4 o;
            o.x = pk2(bflo(hv.x) * gelu_tanh(bflo(gv.x)), bfhi(hv.x) * gelu_tanh(bfhi(gv.x))); o.y = pk2(bflo(hv.y) * gelu_tanh(bflo(gv.y)), bfhi(hv.y) * gelu_tanh(bfhi(gv.y)));
            o.z = pk2(bflo(hv.z) * gelu_tanh(bflo(gv.z)), bfhi(hv.z) * gelu_tanh(bfhi(gv.z))); o.w = pk2(bflo(hv.w) * gelu_tanh(bflo(gv.w)), bfhi(hv.w) * gelu_tanh(bfhi(gv.w)));
            *(u32x4*)(MIX + row * D + n * 64 + cg * 8) = o; }
    }
    LDS_WAIT(); asm volatile("" ::: "memory");
}
__device__ __forceinline__ void lru_load_weights(LAS unsigned char* WL, const float* wa, const float* wi, int n, int tid) {
    for (int i = tid; i < 4 * 4096; i += NTHREADS) { const int mat = i >> 12, w = (i >> 6) & 63, v = i & 63; const int d = mat >> 1;
        const float* src = (mat & 1) ? wi : wa; const float x = src[((size_t)(d * 8 + n) * 64 + w) * 64 + v];
        *(LAS bf16_t*)(WL + (mat * 64 + v) * 144 + w * 2) = (bf16_t)f2bf(x); }
}


__device__ __forceinline__ void att8_phase(LAS unsigned char* lds, const unsigned char* QN8, const unsigned char* KN8, const unsigned char* VT8, bf16_t* MIX, const float* subg, const float lam,
                                           const int vcu, const int G, const int tid, const int lane, const int wave) {
    constexpr int KP = 144, VP = 80, KBYTES = 64 * KP, ABUF = KBYTES + 128 * VP;
    const int r32 = lane & 31, hh = lane >> 5, cc = wave >> 2, wq = wave & 3;
    for (int uu = vcu; uu < NB * 4 * 32; uu += G) {
        const int qb = uu & 31, h = (uu >> 5) & 3, b = uu >> 7;
        const int q0 = qb * 128 + wq * 32;
        v8i32 qf;
        { const unsigned char* qp = QN8 + ((size_t)((b * 4 + h) * SEQ + q0 + r32) * 128 + cc * 64 + hh * 32);
          const u32x4 qa = *(const u32x4*)qp, qb2 = *(const u32x4*)(qp + 16); qf = __builtin_bit_cast(v8i32, __builtin_shufflevector(qa, qb2, 0, 1, 2, 3, 4, 5, 6, 7)); }
        const unsigned char* kbase = KN8 + (size_t)((b * 4 + h) * 4352) * 128 + tid * 16;
        const unsigned char* vbase = VT8 + (size_t)((b * 4 + h) * 128 + (tid >> 2)) * 4352 + (tid & 3) * 16;
        const int kst = (tid >> 3) * KP + (tid & 7) * 16, vst = KBYTES + (tid >> 2) * VP + (tid & 3) * 16;
        u32x4 kr, vr;
        v8i32 ones8;
#pragma unroll
        for (int i = 0; i < 8; ++i) ones8[i] = ((lane & 15) < 2 && (lane & 15) == ((lane >> 4) & 1)) ? 0x38383838 : 0;
        asm volatile("" : "+v"(ones8));
#define ATT_LOAD(t, KR, VR) do { KR = *(const u32x4*)(kbase + (size_t)(t) * 8192); VR = *(const u32x4*)(vbase + (t) * 64); } while (0)
#define ATT_STORE(bufo, KR, VR) do { *(LAS u32x4*)(lds + (bufo) + kst) = KR; *(LAS u32x4*)(lds + (bufo) + vst) = VR; } while (0)
        u32x4 kr1, vr1;
        ATT_LOAD(0, kr, vr); ATT_LOAD(1, kr1, vr1); ATT_STORE(0, kr, vr);
        __syncthreads();
        f32x16 o[4];
#pragma unroll
        for (int eb = 0; eb < 4; ++eb)
#pragma unroll
            for (int r = 0; r < 16; ++r) o[eb][r] = 0.f;
        f32x4 lacc = {0.f, 0.f, 0.f, 0.f};
#define ATT_ITER(t, KRL, VRL, KRS, VRS) do { \
            const int bufo = ((t) & 1) * ABUF; \
            ATT_LOAD(((t) + 2 < 68 ? (t) + 2 : 67), KRL, VRL);          \
            const LAS unsigned char* kl = lds + bufo + r32 * KP + cc * 64 + hh * 32; \
            const v8i32 kf0 = __builtin_bit_cast(v8i32, __builtin_shufflevector(*(const LAS u32x4*)kl, *(const LAS u32x4*)(kl + 16), 0, 1, 2, 3, 4, 5, 6, 7)); \
            const v8i32 kf1 = __builtin_bit_cast(v8i32, __builtin_shufflevector(*(const LAS u32x4*)(kl + 32 * KP), *(const LAS u32x4*)(kl + 32 * KP + 16), 0, 1, 2, 3, 4, 5, 6, 7)); \
            f32x16 s0, s1; \
            _Pragma("unroll") \
            for (int r = 0; r < 16; ++r) { s0[r] = 0.f; s1[r] = 0.f; } \
            s0 = __builtin_amdgcn_mfma_scale_f32_32x32x64_f8f6f4(kf0, qf, s0, 0, 0, 0, 0, 0, 0); \
            s1 = __builtin_amdgcn_mfma_scale_f32_32x32x64_f8f6f4(kf1, qf, s1, 0, 0, 0, 0, 0, 0); \
            _Pragma("unroll") \
            for (int r = 0; r < 16; ++r) { s0[r] = __builtin_amdgcn_exp2f(s0[r]); s1[r] = __builtin_amdgcn_exp2f(s1[r]); } \
            v8i32 pa; \
            _Pragma("unroll") \
            for (int w = 0; w < 4; ++w) { \
                int x; asm volatile("" : "=v"(x)); x = __builtin_amdgcn_cvt_pk_bf8_f32(s0[4 * w], s0[4 * w + 1], x, false); x = __builtin_amdgcn_cvt_pk_bf8_f32(s0[4 * w + 2], s0[4 * w + 3], x, true); pa[w] = x; \
                int y; asm volatile("" : "=v"(y)); y = __builtin_amdgcn_cvt_pk_bf8_f32(s1[4 * w], s1[4 * w + 1], y, false); y = __builtin_amdgcn_cvt_pk_bf8_f32(s1[4 * w + 2], s1[4 * w + 3], y, true); pa[4 + w] = y; } \
            lacc = __builtin_amdgcn_mfma_scale_f32_16x16x128_f8f6f4(pa, ones8, lacc, 1, 0, 0, 0, 0, 0); \
            const LAS unsigned char* vl = lds + bufo + KBYTES + r32 * VP + hh * 32; \
            _Pragma("unroll") \
            for (int eb = 0; eb < 4; ++eb) { \
                const v8i32 vf = __builtin_bit_cast(v8i32, __builtin_shufflevector(*(const LAS u32x4*)(vl + eb * 32 * VP), *(const LAS u32x4*)(vl + eb * 32 * VP + 16), 0, 1, 2, 3, 4, 5, 6, 7)); \
                o[eb] = __builtin_amdgcn_mfma_scale_f32_32x32x64_f8f6f4(pa, vf, o[eb], 1, 0, 0, 0, 0, 0); } \
            ATT_STORE((((t) + 1) & 1) * ABUF, KRS, VRS); \
            __syncthreads(); \
        } while (0)
#pragma unroll 1
        for (int t = 0; t < 68; t += 2) { ATT_ITER(t, kr, vr, kr1, vr1); ATT_ITER(t + 1, kr1, vr1, kr, vr); }
#undef ATT_ITER
#undef ATT_LOAD
#undef ATT_STORE
        LAS float* lb = (LAS float*)(lds + 73728) + wave * 32;
        LAS float* ex = (LAS float*)lds + wq * 4096;
        if ((lane & 15) < 2) {
#pragma unroll
            for (int r = 0; r < 4; ++r) lb[16 * (lane & 15) + 4 * (lane >> 4) + r] = lacc[r]; }
        LDS_WAIT(); asm volatile("" ::: "memory");
        float rl[16];
#pragma unroll
        for (int r = 0; r < 16; ++r) rl[r] = __builtin_amdgcn_rcpf(lb[(r & 3) + 8 * (r >> 2) + 4 * hh]);
        if (cc == 1) {
#pragma unroll
            for (int eb = 0; eb < 4; ++eb)
#pragma unroll
                for (int r = 0; r < 16; ++r) ex[((r & 3) + 8 * (r >> 2) + 4 * hh) * 128 + eb * 32 + r32] = o[eb][r] * rl[r];
        }
        __syncthreads();
        if (cc == 0) {
            float ss[16];
#pragma unroll
            for (int r = 0; r < 16; ++r) ss[r] = 0.f;
#pragma unroll
            for (int eb = 0; eb < 4; ++eb)
#pragma unroll
                for (int r = 0; r < 16; ++r) { const float a = o[eb][r] * rl[r] - lam * ex[((r & 3) + 8 * (r >> 2) + 4 * hh) * 128 + eb * 32 + r32]; o[eb][r] = a; ss[r] += a * a; }
#pragma unroll
            for (int r = 0; r < 16; ++r) { float v = ss[r];
#pragma unroll
                for (int of = 1; of < 32; of <<= 1) v += __shfl_xor(v, of);
                ss[r] = (1.0f - LAM_INIT) * __builtin_amdgcn_rsqf(v * (1.0f / 128.0f) + EPS); }
#pragma unroll
            for (int eb = 0; eb < 4; ++eb) { const float g = subg[eb * 32 + r32];
#pragma unroll
                for (int r = 0; r < 16; ++r) MIX[(size_t)(b * SEQ + q0 + (r & 3) + 8 * (r >> 2) + 4 * hh) * D + 512 + h * 128 + eb * 32 + r32] = (bf16_t)f2bf(o[eb][r] * ss[r] * g); }
        }
        __syncthreads();
    }
}

struct Args {
    const float* in[28]; float* out; unsigned char* ws; int ph_lo, ph_hi, li, pad;
};
enum { I_X = 0, I_C, I_CTX, I_CCTX, I_WADA, I_BADA, I_N1G, I_N2G, I_WIN, I_CONVW, I_CONVB, I_WA, I_BA, I_WI, I_BI, I_LAM, I_QG, I_KG, I_LQ1, I_LK1, I_LQ2, I_LK2, I_SUBG, I_WOUT, I_WR, I_WG, I_WU, I_WDN };

template <bool F8>
__device__ __forceinline__ void transpose_item(const float* W, int K, int N, void* WTv, int mode, LAS float* scr, int item, int lane, float wscale = 1.0f, int ncols = 0) {
    const int nblk = (ncols ? ncols : N) / 32, kb = item / nblk, nb = item % nblk, k0 = 64 * kb, n0 = 32 * nb;
#pragma unroll 8
    for (int i = 0; i < 32; ++i) { const int kk = 2 * i + (lane >> 5); scr[kk * 33 + (lane & 31)] = W[(size_t)(k0 + kk) * N + n0 + (lane & 31)]; }
    LDS_WAIT(); asm volatile("" ::: "memory");
    const int c = lane & 7;
    const int r0 = (mode == 0) ? n0 : ((n0 >> 7) * 256 + (n0 & 127) + (mode == 2 ? 128 : 0));
#pragma unroll
    for (int j = 0; j < 4; ++j) { const int n = (lane >> 3) + 8 * j; const LAS float* sp = scr + (8 * c) * 33 + n;
        if (F8) { u32x2 o; o.x = pk4_fp8(sp[0 * 33] * wscale, sp[1 * 33] * wscale, sp[2 * 33] * wscale, sp[3 * 33] * wscale); o.y = pk4_fp8(sp[4 * 33] * wscale, sp[5 * 33] * wscale, sp[6 * 33] * wscale, sp[7 * 33] * wscale);
            *(u32x2*)((unsigned char*)WTv + (size_t)(r0 + n) * K + k0 + 8 * c) = o; }
        else { u32x4 o; o.x = pk2(sp[0 * 33], sp[1 * 33]); o.y = pk2(sp[2 * 33], sp[3 * 33]); o.z = pk2(sp[4 * 33], sp[5 * 33]); o.w = pk2(sp[6 * 33], sp[7 * 33]);
            *(u32x4*)((bf16_t*)WTv + (size_t)(r0 + n) * K + k0 + 8 * c) = o; } }
    LDS_WAIT(); asm volatile("" ::: "memory");
}

__device__ __forceinline__ void transpose_item_f8(const float* W, int K, int N, unsigned char* WT, int mode, LAS float* scr, int item, int lane, float wscale) {
    const int nblk = N / 32, kb = item / nblk, nb = item % nblk, k0 = 128 * kb, n0 = 32 * nb;
    const int kr = lane >> 3, n4 = lane & 7;
    f32x4 v[16];
    const float* src = W + (size_t)(k0 + kr) * N + n0 + 4 * n4;
#pragma unroll
    for (int i = 0; i < 16; ++i) v[i] = __builtin_nontemporal_load((const f32x4*)(src + (size_t)(8 * i) * N));
#pragma unroll
    for (int i = 0; i < 16; ++i) { const int k = 8 * i + kr; *(LAS f32x4*)(scr + k * 32 + 4 * (n4 ^ (k >> 4))) = v[i]; }
    LDS_WAIT(); asm volatile("" ::: "memory");
    const int kg = lane & 7;
    const int r0 = (mode == 0) ? n0 : ((n0 >> 7) * 256 + (n0 & 127) + (mode == 2 ? 128 : 0));
#pragma unroll
    for (int j = 0; j < 4; ++j) { const int n = (lane >> 3) + 8 * j; const LAS float* sp = scr + (16 * kg) * 32 + (((n >> 2) ^ kg) << 2) + (n & 3);
        u32x4 o;
        o.x = pk4_fp8u(sp[0 * 32] * wscale, sp[1 * 32] * wscale, sp[2 * 32] * wscale, sp[3 * 32] * wscale); o.y = pk4_fp8u(sp[4 * 32] * wscale, sp[5 * 32] * wscale, sp[6 * 32] * wscale, sp[7 * 32] * wscale);
        o.z = pk4_fp8u(sp[8 * 32] * wscale, sp[9 * 32] * wscale, sp[10 * 32] * wscale, sp[11 * 32] * wscale); o.w = pk4_fp8u(sp[12 * 32] * wscale, sp[13 * 32] * wscale, sp[14 * 32] * wscale, sp[15 * 32] * wscale);
        *(u32x4*)(WT + (size_t)(r0 + n) * K + k0 + 16 * kg) = o; }
    LDS_WAIT(); asm volatile("" ::: "memory");
}

constexpr int CONV_IG = (D / 128) * (DE / 32)  , CONV_ID = (DE / 128) * (D / 32)  , CONV_NIT = NE * (2 * CONV_IG + CONV_ID)  ;
constexpr int CONV_P2 = 24;
constexpr int CONV_NP8 = CONV_NIT - 208 * CONV_P2;
__device__ __forceinline__ void conv_item(const Args& args, unsigned char* WGUQ, unsigned char* WDQ, LAS float* scr, int it, int lane) {
    const int e = it / (2 * CONV_IG + CONV_ID); int r = it % (2 * CONV_IG + CONV_ID);
    if (r < CONV_IG) { transpose_item_f8(args.in[I_WG] + (size_t)e * D * DE, D, DE, WGUQ + (size_t)e * GU_N * D, 1, scr, r, lane, 32.0f); return; } r -= CONV_IG;
    if (r < CONV_IG) { transpose_item_f8(args.in[I_WU] + (size_t)e * D * DE, D, DE, WGUQ + (size_t)e * GU_N * D, 2, scr, r, lane, 32.0f); return; } r -= CONV_IG;
    transpose_item_f8(args.in[I_WDN] + (size_t)e * DE * D, DE, D, WDQ + (size_t)e * D * DE, 0, scr, r, lane, 64.0f);
}

__global__ void __launch_bounds__(NTHREADS, 2) mk_fwd(Args args) {
    extern __shared__ __attribute__((aligned(16))) unsigned char lds_raw[];
    LAS unsigned char* lds = (LAS unsigned char*)lds_raw;
    volatile LAS unsigned* MISC = (volatile LAS unsigned*)(lds + MISC_OFF);
    const int tid = threadIdx.x, lane = tid & 63, wave = __builtin_amdgcn_readfirstlane(tid >> 6);
    const int G = gridDim.x; const int bx = blockIdx.x;
    const int vcu = (G % 8 == 0) ? (bx % 8) * (G / 8) + bx / 8 : bx;
    const int gw = vcu * NWAVES + wave, NGW = G * NWAVES;
    unsigned char* ws = args.ws;
    unsigned* ctl = (unsigned*)(ws + WS_CTL);
    float* MODP = (float*)(ws + WS_MODP); float* MOD = (float*)(ws + WS_MOD); float* SCAL = (float*)(ws + WS_SCAL); float* ROPE = SCAL + 1024;
    float* AFF = (float*)(ws + WS_AFF); int* ROWID = (int*)(ws + WS_ROWID); float* GV = (float*)(ws + WS_GV); int* SLOT = (int*)(ws + WS_SLOT);
    bf16_t* WIN_T = (bf16_t*)(ws + WS_WIN); bf16_t* WOUT_T = (bf16_t*)(ws + WS_WOUT); unsigned char* WGUQ = ws + WS_WGU; unsigned char* WDQ = ws + WS_WD; bf16_t* X1 = (bf16_t*)(ws + WS_X1);
    unsigned char* HN8 = ws + WS_HN8; unsigned char* WIN8 = ws + WS_WIN8; bf16_t* HN = (bf16_t*)(ws + WS_HN); bf16_t* PB = (bf16_t*)(ws + WS_P); bf16_t* MIX = (bf16_t*)(ws + WS_MIX); unsigned char* H2Q = ws + WS_H2;
    unsigned char* VT8 = ws + WS_VT; unsigned char* QN8 = ws + WS_QN; unsigned char* KN8 = ws + WS_KN; f32x2* CAGG = (f32x2*)(ws + WS_CAGG); unsigned char* HHQ = ws + WS_HH; unsigned char* YB = ws + WS_Y;
    const float* X = args.in[I_X]; float* OUT = args.out;

    for (int u = tid; u < (LDS_BYTES - LDSCTL_OFF) / 4; u += NTHREADS) ((LAS unsigned*)(lds + LDSCTL_OFF))[u] = 0u;
    __syncthreads();
    XcdBarrier bar; bar.bar = ctl + CW_BAR; bar.x = 0; bar.st = nullptr;
    if (MK_N_LAUNCHES == 1) bar = xcd_barrier_post(ctl + CW_BAR, MISC + 8);
    const int lo = args.ph_lo, hi = args.ph_hi;
#ifndef PHASE_MASK
#define PHASE_MASK 0xfff
#endif
#define IN(k) (((PHASE_MASK >> (k)) & 1) && lo <= (k) && (k) < hi)
#define SEAM(k) do { if (IN(k) && IN((k) + 1)) xcd_barrier(bar); } while (0)

    if (IN(0)) {
        LAS float* scr = (LAS float*)(lds + wave * 8704);
        LAS float* sil = (LAS float*)(lds + 73728);
        for (int i = tid; i < 9 * 1024; i += NTHREADS) { const float v = (i < 8192) ? args.in[I_C][i] : args.in[I_CCTX][i - 8192]; sil[i] = siluf_(v); }
        __syncthreads();
        constexpr int I_IN = (D / 64) * (INW / 32), I_OUT = (D / 64) * (D / 32), I_ADA = 96 * 8, I_IN8 = (D / 64) * (1536 / 32);
        for (int it = gw; it < I_IN + I_OUT + I_ADA + I_IN8; it += NGW) {
            int r = it;
            if (r < I_ADA) {
                const int cg = r >> 3, ks = r & 7; const int col = cg * 64 + lane;
                float a[9];
#pragma unroll
                for (int b = 0; b < 9; ++b) a[b] = 0.f;
                const float* wp = args.in[I_WADA] + (size_t)(ks * 128) * (NMOD * D) + col;
#pragma unroll 4
                for (int k = 0; k < 128; ++k) { const float w = wp[(size_t)k * (NMOD * D)];
#pragma unroll
                    for (int b = 0; b < 9; ++b) a[b] += sil[b * 1024 + ks * 128 + k] * w; }
#pragma unroll
                for (int b = 0; b < 9; ++b) MODP[((size_t)ks * 9 + b) * (NMOD * D) + col] = a[b];
                continue;
            }
            r -= I_ADA;
            if (r < I_IN) { transpose_item<false>(args.in[I_WIN], D, INW, WIN_T, 0, scr, r, lane); continue; } r -= I_IN;
            if (r < I_IN8) { transpose_item<true>(args.in[I_WIN] + 1024, D, INW, WIN8, 0, scr, r, lane, 32.0f, 1536); continue; } r -= I_IN8;
            transpose_item<false>(args.in[I_WOUT], D, D, WOUT_T, 0, scr, r, lane);
        }
    }
    SEAM(0);

    if (IN(1)) {
        LAS float* modl = (LAS float*)lds;
        for (int i = tid; i < 9 * 2048; i += NTHREADS) { const int b = i >> 11, j = i & 2047; float s = args.in[I_BADA][j];
#pragma unroll
            for (int ks = 0; ks < 8; ++ks) s += MODP[((size_t)ks * 9 + b) * (NMOD * D) + j];
            modl[i] = (j < 1024) ? s : (1.0f + s) * args.in[I_N1G][j - 1024]; }
        for (int i = bx * NTHREADS + tid; i < 9 * NMOD * D; i += G * NTHREADS) { const int b = i / (NMOD * D), j = i % (NMOD * D); float s = args.in[I_BADA][j];
#pragma unroll
            for (int ks = 0; ks < 8; ++ks) s += MODP[((size_t)ks * 9 + b) * (NMOD * D) + j];
            MOD[i] = s; }
        if (bx == 0 && wave == 0) {
            const float d1 = wave_sum(args.in[I_LQ1][lane] * args.in[I_LK1][lane]), d2 = wave_sum(args.in[I_LQ2][lane] * args.in[I_LK2][lane]);
            if (lane == 0) SCAL[0] = expf(d1) - expf(d2) + LAM_INIT;
        }
        if (bx == 1) for (int i = tid; i < 1024; i += NTHREADS) { const int pos = i >> 4, p = i & 15; const float inv = exp2f(-(float)p * (13.287712379549449f / 16.0f)); const float ang = (float)pos * inv;
            ROPE[i] = __cosf(ang); ROPE[1024 + i] = __sinf(ang); }
        __syncthreads();
        {
            f32x4 g1[4];
#pragma unroll
            for (int j = 0; j < 4; ++j) g1[j] = *(const f32x4*)(args.in[I_N1G] + 4 * (64 * j + lane));
            f32x4 nv[4];
#define P1_ROWPTR(mm) ((mm) < ML ? X + (size_t)(mm) * D : args.in[I_CTX] + (size_t)((mm) - ML) * D)
            f32x4 nv1[4], nv2[4];
#pragma unroll
            for (int j = 0; j < 4; ++j) { nv[j] = (gw < MT) ? *(const f32x4*)(P1_ROWPTR(gw) + 4 * (64 * j + lane)) : (f32x4){0.f, 0.f, 0.f, 0.f};
                nv1[j] = (gw + NGW < MT) ? *(const f32x4*)(P1_ROWPTR(gw + NGW) + 4 * (64 * j + lane)) : (f32x4){0.f, 0.f, 0.f, 0.f};
                nv2[j] = (gw + 2 * NGW < MT) ? *(const f32x4*)(P1_ROWPTR(gw + 2 * NGW) + 4 * (64 * j + lane)) : (f32x4){0.f, 0.f, 0.f, 0.f}; }
            for (int m = gw; m < MT; m += NGW) {
                const int b = m < ML ? (m >> 12) : 8;
                f32x4 v[4]; float ss = 0.f;
#pragma unroll
                for (int j = 0; j < 4; ++j) { v[j] = nv[j]; nv[j] = nv1[j]; nv1[j] = nv2[j]; }
                if (m + 3 * NGW < MT) {
#pragma unroll
                    for (int j = 0; j < 4; ++j) nv2[j] = *(const f32x4*)(P1_ROWPTR(m + 3 * NGW) + 4 * (64 * j + lane)); }
#pragma unroll
                for (int j = 0; j < 4; ++j) ss += (v[j].x * v[j].x + v[j].y * v[j].y) + (v[j].z * v[j].z + v[j].w * v[j].w);
                const float rstd = __builtin_amdgcn_rsqf(wave_sum(ss) * (1.0f / D) + EPS);
#pragma unroll
                for (int j = 0; j < 4; ++j) { const int col = 4 * (64 * j + lane);
                    const f32x4 sh = *(const LAS f32x4*)(modl + b * 2048 + col), sc = *(const LAS f32x4*)(modl + b * 2048 + 1024 + col);
                    const f32x4 y = (v[j] * rstd) * sc + sh;
                    u32x2 o; o.x = pk2(y.x, y.y); o.y = pk2(y.z, y.w); *(u32x2*)(HN + (size_t)m * D + col) = o;
                    *(unsigned*)(HN8 + (size_t)m * D + col) = pk4_fp8(y.x, y.y, y.z, y.w); }
            }
#undef P1_ROWPTR
        }
    }
    SEAM(1);

    if (IN(2)) {
        { pg8::InProjOrderA S; S.init(G, bx);
          pg8::EpiInProj<false> E{PB, QN8, KN8, ROPE, args.in[I_QG], args.in[I_KG], (LAS float*)(lds + 131072)};
          pg8::gemm_phase<pg8::EpiInProj<false>, pg8::InProjOrderA, false>(lds, HN, WIN_T, D, nullptr, S, E); }
        { pg8::InProjOrderB S; S.init(G, bx);
          pg8::EpiInProj<true> E{PB, QN8, KN8, ROPE, args.in[I_QG], args.in[I_KG], (LAS float*)(lds + 131072)};
          pg8::gemm_phase<pg8::EpiInProj<true>, pg8::InProjOrderB, false, 1>(lds, HN8, WIN8, D, nullptr, S, E); }
        if (G == 256 && bx >= 48) {
            __syncthreads();
            LAS float* scr = (LAS float*)(lds + wave * 16384);
            for (int it = CONV_NIT - (256 - bx) * CONV_P2 + wave; it < CONV_NIT - (255 - bx) * CONV_P2; it += NWAVES) conv_item(args, WGUQ, WDQ, scr, it, lane);
        }
    }
    SEAM(2);

    if (IN(3)) {
        {
            LAS bf16_t* vs = (LAS bf16_t*)(lds + wave * 16896);
            for (int it = gw; it < NB * 4 * 68; it += NGW) {
                const int tile = it % 68, h = (it / 68) & 3, b = it / 272;
                const size_t row0 = tile < 4 ? (size_t)(ML + b * CTX + tile * 64) : (size_t)(b * SEQ + (tile - 4) * 64);
#pragma unroll 4
                for (int i = 0; i < 16; ++i) { const int key = 4 * i + (lane >> 4), c16 = lane & 15;
                    const u32x4 w = *(const u32x4*)(PB + (row0 + key) * INW + 2048 + h * 128 + c16 * 8);
                    LAS unsigned* d = (LAS unsigned*)(vs + key * 132 + c16 * 8); d[0] = w.x; d[1] = w.y; d[2] = w.z; d[3] = w.w; }
                LDS_WAIT(); asm volatile("" ::: "memory");
                const int er = lane >> 2, pq = lane & 3; const int kb0 = 4 * (pq >> 1) + 32 * (pq & 1);
#pragma unroll 2
                for (int i = 0; i < 4; ++i) { const int e = 32 * i + 2 * er; unsigned kw[16];
#pragma unroll
                    for (int jj = 0; jj < 16; ++jj) kw[jj] = *(const LAS unsigned*)(vs + (kb0 + (jj & 3) + 8 * (jj >> 2)) * 132 + e);
                    u32x4 o0, o1;
                    o0.x = pk4_fp8u(bflo(kw[0]), bflo(kw[1]), bflo(kw[2]), bflo(kw[3])); o0.y = pk4_fp8u(bflo(kw[4]), bflo(kw[5]), bflo(kw[6]), bflo(kw[7]));
                    o0.z = pk4_fp8u(bflo(kw[8]), bflo(kw[9]), bflo(kw[10]), bflo(kw[11])); o0.w = pk4_fp8u(bflo(kw[12]), bflo(kw[13]), bflo(kw[14]), bflo(kw[15]));
                    o1.x = pk4_fp8u(bfhi(kw[0]), bfhi(kw[1]), bfhi(kw[2]), bfhi(kw[3])); o1.y = pk4_fp8u(bfhi(kw[4]), bfhi(kw[5]), bfhi(kw[6]), bfhi(kw[7]));
                    o1.z = pk4_fp8u(bfhi(kw[8]), bfhi(kw[9]), bfhi(kw[10]), bfhi(kw[11])); o1.w = pk4_fp8u(bfhi(kw[12]), bfhi(kw[13]), bfhi(kw[14]), bfhi(kw[15]));
                    unsigned char* dst = VT8 + ((size_t)((b * 4 + h) * 128 + e) * 4352 + tile * 64 + pq * 16);
                    *(u32x4*)dst = o0; *(u32x4*)(dst + 4352) = o1; }
                LDS_WAIT(); asm volatile("" ::: "memory");
            }
            __syncthreads();
        }
        {
            const LAS unsigned char* WL = lds; LAS unsigned char* xct = lds + 36864 + wave * 9216;
            const int n = bx & 7, ngrp = G >> 3, jg = bx >> 3;
            lru_load_weights(lds, args.in[I_WA], args.in[I_WI], n, tid);
            __syncthreads();
            if (jg < ngrp) for (int it = jg * NWAVES + wave; it < NB * 68; it += ngrp * NWAVES)
                lru_item<0>(WL, xct, PB, MIX, CAGG, args.in[I_CONVW], args.in[I_CONVB], args.in[I_BA], args.in[I_BI], args.in[I_LAM], n, it / 68, it % 68, lane, 0.f, 0.f);
        }
    }
    SEAM(3);

    if (IN(5)) {
        for (int vbk = bx; vbk < 256; vbk += G) {
            const LAS unsigned char* WL = lds; LAS unsigned char* xct = lds + 36864 + wave * 9216; LAS f32x2* T = (LAS f32x2*)(lds + 110592);
            const int n = vbk & 7, b = (vbk >> 3) & 7, qtr = vbk >> 6;
            __syncthreads();
            lru_load_weights(lds, args.in[I_WA], args.in[I_WI], n, tid);
            float hcf[2], hcb[2];
#pragma unroll
            for (int d = 0; d < 2; ++d) {
                for (int i = tid; i < 68 * 64; i += NTHREADS) T[i] = CAGG[((size_t)(b * 68 + (i >> 6)) * 2 + d) * 512 + n * 64 + (i & 63)];
                __syncthreads();
                if (wave == 0) { float h = 0.f;
#pragma unroll 1
                    for (int bt = 0; bt < 4; ++bt) { f32x2 c[17]; float hin[17];
#pragma unroll
                        for (int i = 0; i < 17; ++i) { const int s = bt * 17 + i; const int j = (d == 0) ? s : (s < 4 ? 3 - s : 71 - s); c[i] = T[j * 64 + lane]; }
#pragma unroll
                        for (int i = 0; i < 17; ++i) { hin[i] = h; h = c[i].x * h + c[i].y; }
#pragma unroll
                        for (int i = 0; i < 17; ++i) { const int s = bt * 17 + i; const int j = (d == 0) ? s : (s < 4 ? 3 - s : 71 - s); T[j * 64 + lane].x = hin[i]; } } }
                __syncthreads();
#pragma unroll
                for (int k = 0; k < 2; ++k) { const float v = T[(4 + qtr * 16 + wave + 8 * k) * 64 + lane].x; if (d == 0) hcf[k] = v; else hcb[k] = v; }
                __syncthreads();
            }
#pragma unroll 1
            for (int k = 0; k < 2; ++k)
                lru_item<1>(WL, xct, PB, MIX, CAGG, args.in[I_CONVW], args.in[I_CONVB], args.in[I_BA], args.in[I_BI], args.in[I_LAM], n, b, 4 + qtr * 16 + wave + 8 * k, lane, k == 0 ? hcf[0] : hcf[1], k == 0 ? hcb[0] : hcb[1]);
        }
        __syncthreads();
#ifdef ATT_VARIANT
#endif
        att8_phase(lds, QN8, KN8, VT8, MIX, args.in[I_SUBG], SCAL[0], vcu, G, tid, lane, wave);
    }
    SEAM(5);

    if (IN(6)) {
        pg8::StaticOrder S; S.init(ML, D, G, bx);
        pg8::EpiResid E{X, X1, MOD, 2};
        pg8::gemm_phase<pg8::EpiResid, pg8::StaticOrder, false>(lds, MIX, WOUT_T, D, nullptr, S, E);
    }
    SEAM(6);

    if (IN(7)) {
        {
            LAS float* Wl = (LAS float*)lds;
            LAS float* Gs = (LAS float*)(lds + 65536);
            LAS float* Shs = (LAS float*)(lds + 69632);
            LAS float* cpart = (LAS float*)(lds + 73728);
            int bprev = -1;
            for (int rb = gw; rb < ML / 16; rb += NGW) {
                const int b = rb >> 8;
                if (b != bprev) {
                    __syncthreads();
                    for (int k = tid; k < D; k += NTHREADS) { Gs[k] = args.in[I_N2G][k] * (1.0f + MOD[(size_t)b * (NMOD * D) + 4 * D + k]); Shs[k] = MOD[(size_t)b * (NMOD * D) + 3 * D + k]; }
                    __syncthreads();
                    for (int i = tid; i < 16 * D; i += NTHREADS) { const int e = i & 15, k = i >> 4;
                        Wl[(2 * (k >> 5) + ((k >> 2) & 1)) * 256 + e * 16 + 4 * ((k >> 3) & 3) + (k & 3)] = Gs[k] * args.in[I_WR][i]; }
                    if (tid < 256) { const int e = tid & 15, part = tid >> 4; float a = 0.f; for (int k = part * 64; k < part * 64 + 64; ++k) a += Shs[k] * args.in[I_WR][k * 16 + e]; cpart[part * 16 + e] = a; }
                    __syncthreads();
                    bprev = b;
                }
                const int row = lane & 15, kq = lane >> 4;
                const bf16_t* xrow = X1 + (size_t)(16 * rb + row) * D + 8 * kq;
                f32x4 acc = (f32x4){0.f, 0.f, 0.f, 0.f}; float ssq = 0.f;
#pragma unroll 4
                for (int s8 = 0; s8 < 32; ++s8) {
                    const u32x4 xw = *(const u32x4*)(xrow + 32 * s8);
                    const f32x4 w0 = *(const LAS f32x4*)(Wl + (2 * s8) * 256 + row * 16 + 4 * kq), w1 = *(const LAS f32x4*)(Wl + (2 * s8 + 1) * 256 + row * 16 + 4 * kq);
                    const float xa[8] = {bflo(xw.x), bfhi(xw.x), bflo(xw.y), bfhi(xw.y), bflo(xw.z), bfhi(xw.z), bflo(xw.w), bfhi(xw.w)};
#pragma unroll
                    for (int j = 0; j < 4; ++j) { acc = __builtin_amdgcn_mfma_f32_16x16x4f32(xa[j], w0[j], acc, 0, 0, 0); ssq += xa[j] * xa[j]; }
#pragma unroll
                    for (int j = 0; j < 4; ++j) { acc = __builtin_amdgcn_mfma_f32_16x16x4f32(xa[4 + j], w1[j], acc, 0, 0, 0); ssq += xa[4 + j] * xa[4 + j]; }
                }
                ssq += __shfl_xor(ssq, 16); ssq += __shfl_xor(ssq, 32);
                const float rstd = __builtin_amdgcn_rsqf(ssq * (1.0f / D) + EPS);
                float cv = 0.f;
#pragma unroll
                for (int p = 0; p < 16; ++p) cv += cpart[p * 16 + row];
#pragma unroll
                for (int r = 0; r < 4; ++r) {
                    const float lg = __shfl(rstd, 4 * kq + r) * acc[r] + cv;
                    float mx = lg;
#pragma unroll
                    for (int o = 1; o < 16; o <<= 1) mx = fmaxf(mx, __shfl_xor(mx, o));
                    const float pe = __expf(lg - mx); float sum = pe;
#pragma unroll
                    for (int o = 1; o < 16; o <<= 1) sum += __shfl_xor(sum, o);
                    AFF[((size_t)(16 * rb + 4 * kq + r)) * 16 + row] = pe / sum;
                }
#pragma unroll 2
                for (int rr = 0; rr < 16; ++rr) {
                    const float rs = __builtin_bit_cast(float, __builtin_amdgcn_readlane(__builtin_bit_cast(int, rstd), rr));
                    const size_t m = (size_t)(16 * rb + rr);
#pragma unroll
                    for (int j = 0; j < 2; ++j) { const int col = 8 * (64 * j + lane);
                        const u32x4 xw = *(const u32x4*)(X1 + m * D + col);
                        const f32x4 g0 = *(const LAS f32x4*)(Gs + col), g1 = *(const LAS f32x4*)(Gs + col + 4), sh0 = *(const LAS f32x4*)(Shs + col), sh1 = *(const LAS f32x4*)(Shs + col + 4);
                        const f32x4 y0 = (f32x4){bflo(xw.x), bfhi(xw.x), bflo(xw.y), bfhi(xw.y)} * rs * g0 + sh0, y1 = (f32x4){bflo(xw.z), bfhi(xw.z), bflo(xw.w), bfhi(xw.w)} * rs * g1 + sh1;
                        u32x2 o; o.x = pk4_fp8(y0.x, y0.y, y0.z, y0.w); o.y = pk4_fp8(y1.x, y1.y, y1.z, y1.w);
                        *(u32x2*)(H2Q + m * D + col) = o; }
                }
            }
        }
    }
    SEAM(7);

    if (IN(8)) {
        LAS unsigned* hist = (LAS unsigned*)lds;
        LAS unsigned* sh = (LAS unsigned*)(lds + 1024);
        for (int lst = bx; lst < NB * NE; lst += G) {
            const int b = lst >> 4, e = lst & 15;
            const float* av = AFF + (size_t)b * SEQ * 16 + e;
            unsigned key[8];
#pragma unroll
            for (int i = 0; i < 8; ++i) key[i] = __builtin_bit_cast(unsigned, av[(size_t)(tid * 8 + i) * 16]);
            unsigned prefix = 0u, kk = CAP;
            for (int pass = 0; pass < 4; ++pass) {
                const int shift = 24 - 8 * pass; const unsigned himask = pass == 0 ? 0u : (0xffffffffu << (shift + 8));
                if (tid < 256) hist[tid] = 0u;
                __syncthreads();
#pragma unroll
                for (int i = 0; i < 8; ++i) if ((key[i] & himask) == prefix) atomicAdd((unsigned*)&hist[(key[i] >> shift) & 255u], 1u);
                __syncthreads();
                if (tid < 256) { const unsigned c = hist[255 - tid]; unsigned inc = c;
#pragma unroll
                    for (int o = 1; o < 64; o <<= 1) { const unsigned t2 = __shfl_up(inc, o); if (lane >= o) inc += t2; }
                    if (lane == 63) sh[48 + wave] = inc;
                    sh[64 + tid] = inc; sh[320 + tid] = c; }
                __syncthreads();
                if (tid < 256) { unsigned base = 0u; for (int w = 0; w < wave; ++w) base += sh[48 + w];
                    const unsigned inc = sh[64 + tid] + base, c = sh[320 + tid];
                    if (inc >= kk && inc - c < kk) { sh[0] = prefix | ((unsigned)(255 - tid) << shift); sh[1] = kk - (inc - c); } }
                __syncthreads();
                prefix = sh[0]; kk = sh[1];
                __syncthreads();
            }
            int ce = 0;
#pragma unroll
            for (int i = 0; i < 8; ++i) ce += (key[i] == prefix) ? 1 : 0;
            int inc = ce;
#pragma unroll
            for (int o = 1; o < 64; o <<= 1) { const int t2 = __shfl_up(inc, o); if (lane >= o) inc += t2; }
            if (lane == 63) sh[16 + wave] = (unsigned)inc;
            __syncthreads();
            int ebase = inc - ce;
            for (int w = 0; w < wave; ++w) ebase += (int)sh[16 + w];
            int cs = 0; unsigned selmask = 0u; int er = ebase;
#pragma unroll
            for (int i = 0; i < 8; ++i) { bool s = key[i] > prefix; if (key[i] == prefix) { s = er < (int)kk; ++er; } if (s) { selmask |= 1u << i; ++cs; } }
            int inc2 = cs;
#pragma unroll
            for (int o = 1; o < 64; o <<= 1) { const int t2 = __shfl_up(inc2, o); if (lane >= o) inc2 += t2; }
            if (lane == 63) sh[32 + wave] = (unsigned)inc2;
            __syncthreads();
            int sbase = inc2 - cs;
            for (int w = 0; w < wave; ++w) sbase += (int)sh[32 + w];
#pragma unroll
            for (int i = 0; i < 8; ++i) { const int t = tid * 8 + i; int slot = -1;
                if (selmask & (1u << i)) { slot = sbase++; ROWID[(e * NB + b) * CAP + slot] = b * SEQ + t; GV[(e * NB + b) * CAP + slot] = __builtin_bit_cast(float, key[i]); }
                ((short*)SLOT)[((size_t)b * SEQ + t) * 16 + e] = (short)slot; }
            __syncthreads();
        }
        __syncthreads();
        {
            LAS float* scr = (LAS float*)(lds + wave * 16384);
            const int NIT = (G == 256) ? CONV_NP8 : CONV_NIT;
            int it0, it1;
            if (G == 256) { constexpr int N1 = 107, LO = 128 * N1; if (bx < 128) { it0 = N1 * bx; it1 = it0 + N1; } else { it0 = LO + (int)((long)(CONV_NP8 - LO) * (bx - 128) / 128); it1 = LO + (int)((long)(CONV_NP8 - LO) * (bx - 127) / 128); } }
            else { it0 = (int)((long)NIT * bx / G); it1 = (int)((long)NIT * (bx + 1) / G); }
            for (int it = it0 + wave; it < it1; it += NWAVES) conv_item(args, WGUQ, WDQ, scr, it, lane);
        }
    }
    SEAM(8);

    if (IN(9)) {
        pg8::StaticOrder S; S.init(NE * NB * CAP, GU_N, G, bx, 16, GU_N / 256);
        pg8::EpiSwiGLU8 E{HHQ};
        pg8::gemm_phase<pg8::EpiSwiGLU8, pg8::StaticOrder, true, 1, false>(lds, H2Q, WGUQ, D, ROWID, S, E);
    }
    SEAM(9);

    if (IN(10)) {
        pg8::StaticOrder S; S.init(NE * NB * CAP, D, G, bx, 16, D / 256);
        pg8::EpiScaleBf16 E{YB, GV, 32.0f / 256.0f};
        pg8::gemm_phase<pg8::EpiScaleBf16, pg8::StaticOrder, false, 1>(lds, HHQ, WDQ, DE, nullptr, S, E);
    }
    SEAM(10);

    if (IN(11)) {
        LAS short* sl = (LAS short*)(lds + wave * 512);
        const short* SLOT16 = (const short*)SLOT;
        for (int m0 = gw * 16; m0 < ML; m0 += NGW * 16) {
            const int b = m0 >> 12;
            *(LAS u32x2*)((LAS unsigned char*)sl + lane * 8) = *(const u32x2*)((const unsigned char*)SLOT16 + (size_t)m0 * 32 + lane * 8);
            f32x4 g[2][2];
#pragma unroll
            for (int j = 0; j < 2; ++j) { g[j][0] = *(const f32x4*)(MOD + (size_t)b * (NMOD * D) + 5 * D + 8 * (64 * j + lane)); g[j][1] = *(const f32x4*)(MOD + (size_t)b * (NMOD * D) + 5 * D + 8 * (64 * j + lane) + 4); }
            LDS_WAIT(); asm volatile("" ::: "memory");
            u32x4 nx[2];
#pragma unroll
            for (int j = 0; j < 2; ++j) nx[j] = *(const u32x4*)(X1 + (size_t)m0 * D + 8 * (64 * j + lane));
#pragma unroll 1
            for (int r = 0; r < 16; ++r) {
                const int m = m0 + r;
                u32x4 xv[2];
#pragma unroll
                for (int j = 0; j < 2; ++j) xv[j] = nx[j];
                if (r < 15) {
#pragma unroll
                    for (int j = 0; j < 2; ++j) nx[j] = *(const u32x4*)(X1 + (size_t)(m + 1) * D + 8 * (64 * j + lane)); }
                const int sv = (lane < 16) ? (int)sl[r * 16 + lane] : -1;
                unsigned mk = (unsigned)(__ballot(sv >= 0) & 0xffffull);
                f32x4 a[2][2];
#pragma unroll
                for (int j = 0; j < 2; ++j) { a[j][0] = (f32x4){0.f, 0.f, 0.f, 0.f}; a[j][1] = (f32x4){0.f, 0.f, 0.f, 0.f}; }
                do {
                    const unsigned char* yp[4]; float wv[4];
#pragma unroll
                    for (int q = 0; q < 4; ++q) { const bool v = mk != 0u; const int e = v ? __builtin_ctz(mk) : 0; mk = v ? (mk & (mk - 1u)) : 0u;
                        int sx = __builtin_amdgcn_readlane(sv, e); sx = v ? sx : 0;
                        yp[q] = YB + ((size_t)(e * NB + b) * CAP + sx) * D; wv[q] = v ? (1.0f / 32.0f) : 0.0f; }
                    u32x2 w[4][2];
#pragma unroll
                    for (int q = 0; q < 4; ++q)
#pragma unroll
                        for (int j = 0; j < 2; ++j) w[q][j] = *(const u32x2*)(yp[q] + 8 * (64 * j + lane));
#pragma unroll
                    for (int q = 0; q < 4; ++q)
#pragma unroll
                        for (int j = 0; j < 2; ++j) { const f32x2 p0 = __builtin_amdgcn_cvt_pk_f32_fp8((int)w[q][j].x, false), p1 = __builtin_amdgcn_cvt_pk_f32_fp8((int)w[q][j].x, true), p2 = __builtin_amdgcn_cvt_pk_f32_fp8((int)w[q][j].y, false), p3 = __builtin_amdgcn_cvt_pk_f32_fp8((int)w[q][j].y, true);
                            a[j][0] += wv[q] * (f32x4){p0.x, p0.y, p1.x, p1.y}; a[j][1] += wv[q] * (f32x4){p2.x, p2.y, p3.x, p3.y}; }
                } while (mk != 0u);
#pragma unroll
                for (int j = 0; j < 2; ++j) { float* op = OUT + (size_t)m * D + 8 * (64 * j + lane);
                    *(f32x4*)op = (f32x4){bflo(xv[j].x), bfhi(xv[j].x), bflo(xv[j].y), bfhi(xv[j].y)} + g[j][0] * a[j][0];
                    *(f32x4*)(op + 4) = (f32x4){bflo(xv[j].z), bfhi(xv[j].z), bflo(xv[j].w), bfhi(xv[j].w)} + g[j][1] * a[j][1]; }
            }
            LDS_WAIT(); asm volatile("" ::: "memory");
        }
    }
#undef IN
#undef SEAM
}

constexpr int N_PHASES = 12;

extern "C" void kernel_launch(void* const* d_in, const int* in_sizes, int n_in, void* d_out, int out_size, void* d_ws, size_t ws_size, hipStream_t stream) {
    static int grid = 0;
    if (grid == 0) {
        if (n_in != 28 || out_size != ML * D || ws_size < WS_END) { fprintf(stderr, "kernel_launch: unexpected shapes: n_in %d out %d ws %zu (need %zu)\n", n_in, out_size, ws_size, (size_t)WS_END); grid = -1; return; }
        int dev = 0, cus = 0;
        if (hipGetDevice(&dev) != hipSuccess || hipDeviceGetAttribute(&cus, hipDeviceAttributeMultiprocessorCount, dev) != hipSuccess) { grid = -1; return; }
        if (hipFuncSetAttribute((const void*)mk_fwd, hipFuncAttributeMaxDynamicSharedMemorySize, LDS_BYTES) != hipSuccess) { fprintf(stderr, "kernel_launch: hipFuncSetAttribute failed\n"); grid = -1; return; }
        int per_cu = 0;
        if (hipOccupancyMaxActiveBlocksPerMultiprocessor(&per_cu, (const void*)mk_fwd, NTHREADS, LDS_BYTES) != hipSuccess || per_cu < 1) fprintf(stderr, "kernel_launch: occupancy query says %d\n", per_cu);
        (void)hipGetLastError();
        grid = cus;
    }
    if (grid < 0) return;
    hipMemsetAsync((char*)d_ws + WS_CTL, 0, CTL_ZERO_BYTES, stream);
    Args a{};
    for (int i = 0; i < 28; ++i) a.in[i] = (const float*)d_in[i];
    a.out = (float*)d_out; a.ws = (unsigned char*)d_ws;
    if (MK_N_LAUNCHES == 1) {
        a.ph_lo = 0; a.ph_hi = N_PHASES; a.li = 0;
        hipLaunchKernelGGL(mk_fwd, dim3(grid), dim3(NTHREADS), LDS_BYTES, stream, a);
    } else {
        for (int p = 0; p < N_PHASES; ++p) { a.ph_lo = p; a.ph_hi = p + 1; a.li = 0; hipLaunchKernelGGL(mk_fwd, dim3(grid), dim3(NTHREADS), LDS_BYTES, stream, a); }
    }
}
```

```cpp
#include <hip/hip_runtime.h>
#include <cstdio>
#include <cstdint>

#ifndef MK_N_LAUNCHES
#define MK_N_LAUNCHES 1
#endif

#define GAS __attribute__((address_space(1)))
#define LAS __attribute__((address_space(3)))
typedef unsigned short bf16_t;
typedef short bf16x8 __attribute__((ext_vector_type(8)));
typedef float f32x4 __attribute__((ext_vector_type(4)));
typedef float f32x2 __attribute__((ext_vector_type(2)));
typedef unsigned u32x4 __attribute__((ext_vector_type(4)));
typedef unsigned u32x2 __attribute__((ext_vector_type(2)));
typedef float f32x16 __attribute__((ext_vector_type(16)));
typedef int v8i32 __attribute__((ext_vector_type(8)));

constexpr int D = 1024, NB = 8, SEQ = 4096, CTX = 256, ML = NB * SEQ, MC = NB * CTX, MT = ML + MC;
constexpr int INW = 2560, LRUW = 512, NE = 16, DE = 2816, CAP = 512, NMOD = 6;
constexpr int GU_N = 2 * DE;
constexpr float EPS = 1e-6f;
constexpr float QSCALE = 0.125f * 1.4426950408889634f;
constexpr float LAM_INIT = 0.2f;
constexpr int NWAVES = 8, NTHREADS = 512;

constexpr size_t MiB = 1u << 20;
constexpr size_t WS_CTL = 0, CTL_ZERO_BYTES = 1 * MiB;
constexpr size_t WS_MODP = 1 * MiB;
constexpr size_t WS_MOD = 3 * MiB;
constexpr size_t WS_LWI = 2 * MiB;
constexpr size_t WS_WLP = 1 * MiB;
constexpr size_t WS_SCAL = 3 * MiB + 512 * 1024;
constexpr size_t WS_AFF = 4 * MiB;
constexpr size_t WS_ROWID = 6 * MiB;
constexpr size_t WS_GV = 6 * MiB + 512 * 1024;
constexpr size_t WS_SLOT = 7 * MiB;
constexpr size_t WS_WIN = 10 * MiB;
constexpr size_t WS_WOUT = 15 * MiB;
constexpr size_t WS_HN = 18 * MiB;
constexpr size_t WS_MIX = 18 * MiB;
constexpr size_t WS_H2 = 18 * MiB;
constexpr size_t WS_P = 86 * MiB;
constexpr size_t WS_X1 = 86 * MiB;
constexpr size_t WS_QN = 256 * MiB;
constexpr size_t WS_KN = 272 * MiB;
constexpr size_t WS_VT = 289 * MiB;
constexpr size_t WS_WD = 306 * MiB;
constexpr size_t WS_HN8 = 350 * MiB;
constexpr size_t WS_WIN8 = 384 * MiB;
constexpr size_t WS_HH = 350 * MiB;
constexpr size_t WS_Y = 526 * MiB;
constexpr size_t WS_WGU = 590 * MiB;
constexpr size_t WS_CAGG = 694 * MiB;
constexpr size_t WS_END = 702 * MiB;
constexpr int CW_TMO = 0, CW_BAR = 4096;

constexpr int RING_BYTES = 131072;
constexpr int LDSCTL_OFF = 147456, MISC_OFF = LDSCTL_OFF + 320;
constexpr int LDS_BYTES = 148480;

#define RLX_AGENT __ATOMIC_RELAXED, __HIP_MEMORY_SCOPE_AGENT
#define LDS_WAIT() asm volatile("s_waitcnt lgkmcnt(0)" ::: "memory")
#define VM_WAIT() asm volatile("s_waitcnt vmcnt(0)" ::: "memory")
__device__ __forceinline__ unsigned f2bf(float f) { unsigned u = __builtin_bit_cast(unsigned, f); return (u + 0x7fffu + ((u >> 16) & 1u)) >> 16; }
__device__ __forceinline__ unsigned pk2(float lo, float hi) { return f2bf(lo) | (f2bf(hi) << 16); }
__device__ __forceinline__ float bflo(unsigned w) { return __builtin_bit_cast(float, w << 16); }
__device__ __forceinline__ float bfhi(unsigned w) { return __builtin_bit_cast(float, w & 0xffff0000u); }
__device__ __forceinline__ float bf2f(bf16_t h) { return __builtin_bit_cast(float, ((unsigned)h) << 16); }
__device__ __forceinline__ float wave_sum(float v) {
#pragma unroll
    for (int o = 1; o < 64; o <<= 1) v += __shfl_xor(v, o);
    return v;
}
__device__ __forceinline__ float sigmoidf_(float x) { return __builtin_amdgcn_rcpf(1.0f + __builtin_amdgcn_exp2f(-1.4426950408889634f * x)); }
__device__ __forceinline__ float siluf_(float x) { return x / (1.0f + __expf(-x)); }
__device__ __forceinline__ float gelu_tanh(float x) { const float u = 0.7978845608028654f * (x + 0.044715f * x * x * x); const float e = __builtin_amdgcn_exp2f(2.8853900817779268f * u); const float t = 1.0f - 2.0f * __builtin_amdgcn_rcpf(e + 1.0f); return 0.5f * x * (1.0f + t); }

__device__ __forceinline__ unsigned pk4_fp8(float a, float b, float c, float d) {
    a = __builtin_amdgcn_fmed3f(a, -448.f, 448.f); b = __builtin_amdgcn_fmed3f(b, -448.f, 448.f); c = __builtin_amdgcn_fmed3f(c, -448.f, 448.f); d = __builtin_amdgcn_fmed3f(d, -448.f, 448.f);
    int w = 0; w = __builtin_amdgcn_cvt_pk_fp8_f32(a, b, w, false); w = __builtin_amdgcn_cvt_pk_fp8_f32(c, d, w, true); return (unsigned)w; }
__device__ __forceinline__ unsigned pk4_fp8u(float a, float b, float c, float d) {
    int w = 0; w = __builtin_amdgcn_cvt_pk_fp8_f32(a, b, w, false); w = __builtin_amdgcn_cvt_pk_fp8_f32(c, d, w, true); return (unsigned)w; }
#define XB_TMO      128
#define XB_XCNT(j)  (256  + 64 * (j))
#define XB_XSUB(j)  (1280 + 64 * (j))
#define XB_XGEN(j)  (2304 + 64 * (j))
#define XB_TOP      3328
#define XB_TOPGEN   3392
#define XCD_BAR_WORDS 3456
#define XB_SPIN_CAP (1u << 22)
__device__ __forceinline__ unsigned xb_ld(unsigned* p)              { return __hip_atomic_load(p, __ATOMIC_RELAXED, __HIP_MEMORY_SCOPE_AGENT); }
__device__ __forceinline__ unsigned xb_add(unsigned* p, unsigned v) { return __hip_atomic_fetch_add(p, v, __ATOMIC_RELAXED, __HIP_MEMORY_SCOPE_AGENT); }
__device__ __forceinline__ unsigned xb_xcc_id() { return (unsigned)__builtin_amdgcn_s_getreg((3 << 11) | 20) & 0xFu; }
#define XB_SPIN(cond, bar) do { unsigned _sp = 0; while (cond) { __builtin_amdgcn_s_sleep(1); \
    if ((++_sp & 255u) == 0u) { if (xb_ld(&(bar)[XB_TMO])) break; if (_sp > XB_SPIN_CAP) { atomicAdd(&(bar)[XB_TMO], 1u); break; } } } } while (0)
struct XcdBarrier { unsigned* bar; unsigned x; volatile LAS unsigned* st; };
__device__ __forceinline__ XcdBarrier xcd_barrier_post(unsigned* bar, volatile LAS unsigned* st) {
    XcdBarrier b; b.bar = bar; b.x = xb_xcc_id(); b.st = st;
    if (threadIdx.x == 0) (void)xb_add(&bar[XB_XCNT(b.x)], 1u);
    return b;
}
__device__ __forceinline__ void xcd_barrier_complete(unsigned* bar, unsigned x, unsigned& nloc, unsigned& nx) {
    const unsigned G = gridDim.x * gridDim.y * gridDim.z;
    unsigned sum, cnt, mine, sp = 0u;
    for (;;) {
        sum = 0u; cnt = 0u; mine = 0u;
#pragma unroll
        for (unsigned j = 0; j < 16; ++j) { const unsigned c = xb_ld(&bar[XB_XCNT(j)]); sum += c; cnt += (c > 0u) ? 1u : 0u; mine = (j == x) ? c : mine; }
        if (sum == G) break;
        __builtin_amdgcn_s_sleep(1);
        if ((++sp & 255u) == 0u) { if (xb_ld(&bar[XB_TMO])) break; if (sp > XB_SPIN_CAP) { atomicAdd(&bar[XB_TMO], 1u); break; } }
    }
    nloc = mine > 0u ? mine : 1u; nx = cnt > 0u ? cnt : 1u;
}
__device__ __forceinline__ void xcd_barrier(const XcdBarrier& b) {
    asm volatile("s_waitcnt vmcnt(0)" ::: "memory");
    __syncthreads();
    if (threadIdx.x == 0) {
        unsigned* bar = b.bar;
        __builtin_amdgcn_s_waitcnt(0);
        unsigned nloc = b.st[0], nx = b.st[1];
        if (nloc == 0u) { xcd_barrier_complete(bar, b.x, nloc, nx); b.st[0] = nloc; b.st[1] = nx; }
        const unsigned old = xb_add(&bar[XB_XSUB(b.x)], 1u);
        const unsigned gen = old / nloc;
        if (old + 1u == (gen + 1u) * nloc) {
            __builtin_amdgcn_fence(__ATOMIC_RELEASE, "agent");
            asm volatile("s_waitcnt vmcnt(0)" ::: "memory");
            const unsigned og = xb_add(&bar[XB_TOP], 1u);
            const unsigned tg = og / nx;
            if (og + 1u == (tg + 1u) * nx) xb_add(&bar[XB_TOPGEN], 1u);
            else XB_SPIN(xb_ld(&bar[XB_TOPGEN]) == tg, bar);
            __builtin_amdgcn_fence(__ATOMIC_ACQUIRE, "agent");
            xb_add(&bar[XB_XGEN(b.x)], 1u);
            asm volatile("s_waitcnt vmcnt(0)" ::: "memory");
        } else {
            XB_SPIN(xb_ld(&bar[XB_XGEN(b.x)]) == gen, bar);
            __builtin_amdgcn_fence(__ATOMIC_ACQUIRE, "agent");
            asm volatile("s_waitcnt vmcnt(0)" ::: "memory");
        }
    }
    __syncthreads();
}

namespace pg8 {
constexpr int BM = 256, BK = 64, HALF = 128, HTB = HALF * BK * 2, STAGE_BYTES = 8 * HTB, NXCD = 8, WGM = 8;
__host__ __device__ __forceinline__ int lds_byte(int r, int c) { const int st = (r >> 4) * 2 + (c >> 5), rr = r & 15, cc = c & 31, ob = rr * 64 + cc * 2; return st * 1024 + (ob ^ (((ob >> 9) & 1) << 5)); }
__host__ __device__ __forceinline__ void stage_rc(int b, int& R, int& C) { const int st = b / 1024, sb = b % 1024, swz = sb ^ (((sb >> 9) & 1) << 5); R = (st >> 1) * 16 + swz / 64; C = (st & 1) * 32 + (swz % 64) / 2; }
__host__ __device__ __forceinline__ int perm32(int rho) { const int n = rho >> 4, i = rho & 15; return 8 * (i >> 2) + 4 * n + (i & 3); }

__device__ __forceinline__ float xhalf32(float x, int hi) {
    const unsigned uu = __builtin_bit_cast(unsigned, x); const auto rr = __builtin_amdgcn_permlane32_swap(uu, uu, false, false);
    return __builtin_bit_cast(float, hi ? rr[0] : rr[1]); }
struct Unit { int pm, pn, pb; };
struct StaticOrder {
    int nM, nN, nwg, G, c, bgrp, bmul;
    __device__ void init(int M, int N, int G_, int c_, int bgrp_ = 1 << 30, int bmul_ = 0) { nM = M / BM; nN = N / BM; nwg = nM * nN; G = G_; c = c_; bgrp = bgrp_; bmul = bmul_; }
    __device__ bool next(int i, Unit& u) const {
        const long L = (long)i * G + c; if (L >= nwg) return false;
        int wgid = (int)L; { const int q = nwg / NXCD, r = nwg % NXCD, xcd = wgid % NXCD, off = wgid / NXCD; wgid = (xcd < r ? xcd * (q + 1) : r * (q + 1) + (xcd - r) * q) + off; }
        const int nig = WGM * nN, gid = wgid / nig, fm = gid * WGM, gsz = (nM - fm) < WGM ? (nM - fm) : WGM;
        u.pm = fm + ((wgid % nig) % gsz); u.pn = (wgid % nig) / gsz; u.pb = (u.pm / bgrp) * bmul + u.pn; return true;
    }
};
struct InProjOrderA {
    StaticOrder lat; int G, c;
    __device__ void init(int G_, int c_) { lat.init(ML, 1024, G_, c_); G = G_; c = c_; }
    __device__ bool next(int i, Unit& u) const {
        const int L = i * G + c;
        if (L < 512) return lat.next(i, u);
        const int j = L - 512; if (j >= 16) return false;
        u.pm = 128 + (j >> 1); u.pn = j & 1; u.pb = u.pn; return true;
    }
};
struct InProjOrderB {
    StaticOrder lat; int G, c;
    __device__ void init(int G_, int c_) { lat.init(ML, 1536, G_, c_); G = G_; c = c_; }
    __device__ bool next(int i, Unit& u) const {
        const int L = i * G + c;
        if (L < 768) { if (!lat.next(i, u)) return false; u.pb = u.pn; u.pn += 4; return true; }
        int j = L - 768; if (G == 256) j -= 16;
        if (j < 0 || j >= 32) return false;
        u.pm = 128 + (j >> 2); u.pn = 6 + (j & 3); u.pb = u.pn - 4; return true;
    }
};
__device__ __forceinline__ unsigned cvt_pk_bf16(float lo, float hi) { unsigned r; asm volatile("v_cvt_pk_bf16_f32 %0, %1, %2" : "=v"(r) : "v"(lo), "v"(hi)); return r; }

struct EpiBf16 {
    static constexpr bool PERM = true;
    bf16_t* O; int ldc;
    __device__ __forceinline__ void operator()(const f32x4 (&acc)[2][2][4][2], const Unit& u, int wr, int wc, int fr, int fq) const {
        const int row0 = u.pm * BM + wr * 64 + fr; const int col0 = u.pn * BM + wc * 32 + 8 * fq;
#pragma unroll
        for (int ai = 0; ai < 2; ++ai)
#pragma unroll
            for (int m = 0; m < 4; ++m) { bf16_t* rowp = O + (size_t)(row0 + ai * HALF + m * 16) * ldc + col0;
#pragma unroll
                for (int bj = 0; bj < 2; ++bj) { const f32x4 v0 = acc[ai][bj][m][0], v1 = acc[ai][bj][m][1];
                    u32x4 w; w.x = cvt_pk_bf16(v0[0], v0[1]); w.y = cvt_pk_bf16(v0[2], v0[3]); w.z = cvt_pk_bf16(v1[0], v1[1]); w.w = cvt_pk_bf16(v1[2], v1[3]);
                    *(u32x4*)(rowp + bj * HALF) = w; } }
    }
};
template <bool F8> struct EpiInProj {
    static constexpr bool PERM = true; static constexpr float pre = F8 ? (1.0f / 32.0f) : 1.0f;
    bf16_t* PB; unsigned char* QN8; unsigned char* KN8; const float* rope; const float* qg; const float* kg; LAS float* xs;
    __device__ __forceinline__ void operator()(const f32x4 (&acc)[2][2][4][2], const Unit& u, int wr, int wc, int fr, int fq) const {
        const int row0 = u.pm * BM + wr * 64 + fr;
        if (!F8 || u.pn >= 8) {
            const int col0 = u.pn * BM + wc * 32 + 8 * fq;
#pragma unroll
            for (int ai = 0; ai < 2; ++ai)
#pragma unroll
                for (int m = 0; m < 4; ++m) { bf16_t* rowp = PB + (size_t)(row0 + ai * HALF + m * 16) * INW + col0;
#pragma unroll
                    for (int bj = 0; bj < 2; ++bj) { const f32x4 v0 = acc[ai][bj][m][0] * pre, v1 = acc[ai][bj][m][1] * pre;
                        u32x4 w; w.x = cvt_pk_bf16(v0[0], v0[1]); w.y = cvt_pk_bf16(v0[2], v0[3]); w.z = cvt_pk_bf16(v1[0], v1[1]); w.w = cvt_pk_bf16(v1[2], v1[3]);
                        *(u32x4*)(rowp + bj * HALF) = w; } }
            return;
        }
        if constexpr (F8) {
        const bool isq = u.pn < 6, lat = u.pm < (ML / BM);
        const int wave = wr * 4 + wc, axis = wc & 1; const bool x2half = fq >= 2; const int p0 = 8 * (fq & 1);
        LAS float* xw = xs + (wave * 256 + fr), * xp = xs + ((wave ^ 1) * 256 + fr);
        asm volatile("" : "+v"(xw), "+v"(xp));
#pragma unroll
        for (int ai = 0; ai < 2; ++ai)
#pragma unroll
            for (int bj = 0; bj < 2; ++bj)
#pragma unroll
                for (int m = 0; m < 4; ++m) { const f32x4 a0 = acc[ai][bj][m][0], a1 = acc[ai][bj][m][1];
                    float p = (a0[0] * a0[0] + a0[1] * a0[1]) + (a0[2] * a0[2] + a0[3] * a0[3]) + (a1[0] * a1[0] + a1[1] * a1[1]) + (a1[2] * a1[2] + a1[3] * a1[3]);
                    p += __shfl_xor(p, 16); p += __shfl_xor(p, 32);
                    if (fq == 0) xw[(ai * 8 + bj * 4 + m) * 16] = p; }
        asm volatile("s_waitcnt lgkmcnt(0)" ::: "memory"); __builtin_amdgcn_s_barrier(); asm volatile("" ::: "memory");
        f32x4 g0, g1;
        { const float* gp = (isq ? qg : kg) + 32 * axis + 8 * fq; g0 = *(const f32x4*)gp; g1 = *(const f32x4*)(gp + 4); if (isq) { g0 = g0 * QSCALE; g1 = g1 * QSCALE; } }
#pragma unroll
        for (int ai = 0; ai < 2; ++ai)
#pragma unroll
            for (int m = 0; m < 4; ++m) {
                const int row = row0 + ai * HALF + m * 16; const int b = lat ? (row >> 12) : ((row - ML) >> 8); const int t = lat ? (row & 4095) : ((row - ML) & 255);
                f32x4 c0 = (f32x4){1.f, 1.f, 1.f, 1.f}, c1 = c0, s0 = (f32x4){0.f, 0.f, 0.f, 0.f}, s1 = s0;
                if (lat) { const int pos = axis ? (t & 63) : (t >> 6); const float* rp = rope + pos * 16 + p0;
                    c0 = *(const f32x4*)rp; c1 = *(const f32x4*)(rp + 4); s0 = *(const f32x4*)(rp + 1024); s1 = *(const f32x4*)(rp + 1028); if (!x2half) { s0 = -s0; s1 = -s1; } }
#pragma unroll
                for (int bj = 0; bj < 2; ++bj) {
                    const float tot = xw[(ai * 8 + bj * 4 + m) * 16] + xp[(ai * 8 + bj * 4 + m) * 16];
                    const float rstd = pre * __builtin_amdgcn_rsqf(tot * (pre * pre * (1.0f / 64.0f)) + EPS);
                    const f32x4 v0 = acc[ai][bj][m][0] * rstd * g0, v1 = acc[ai][bj][m][1] * rstd * g1;
                    float o[8];
#pragma unroll
                    for (int i = 0; i < 4; ++i) { o[i] = v0[i] * c0[i] + xhalf32(v0[i], fq >> 1) * s0[i]; o[4 + i] = v1[i] * c1[i] + xhalf32(v1[i], fq >> 1) * s1[i]; }
                    const int gc = (u.pn & 1) * 4 + 2 * bj + (wc >> 1); const int h = gc >> 1, c = gc & 1;
                    const unsigned doff = isq ? (unsigned)(((b * 4 + h) * SEQ + t) * 128 + c * 64 + 32 * axis + 8 * fq) : (unsigned)(((b * 4 + h) * 4352 + (lat ? CTX + t : t)) * 128 + c * 64 + 32 * axis + 8 * fq);
                    u32x2 ov; ov.x = pk4_fp8u(o[0], o[1], o[2], o[3]); ov.y = pk4_fp8u(o[4], o[5], o[6], o[7]);
                    *(u32x2*)((isq ? QN8 : KN8) + doff) = ov;
                    asm volatile("" ::: "memory"); }
                asm volatile("" ::: "memory");
            }
        }
    }
};
struct EpiResid {
    static constexpr bool PERM = true;
    const float* x; bf16_t* out; const float* mod;
    int gch;
    __device__ __forceinline__ void operator()(const f32x4 (&acc)[2][2][4][2], const Unit& u, int wr, int wc, int fr, int fq) const {
        const int row0 = u.pm * BM + wr * 64 + fr, col0 = u.pn * BM + wc * 32 + 8 * fq; const int b = u.pm >> 4;
        f32x4 gv[2][2];
#pragma unroll
        for (int bj = 0; bj < 2; ++bj)
#pragma unroll
            for (int n = 0; n < 2; ++n) gv[bj][n] = *(const f32x4*)(mod + (size_t)b * (NMOD * D) + gch * D + col0 + bj * HALF + n * 4);
#pragma unroll
        for (int ai = 0; ai < 2; ++ai)
#pragma unroll
            for (int m = 0; m < 4; ++m) { const size_t off = (size_t)(row0 + ai * HALF + m * 16) * D + col0;
#pragma unroll
                for (int bj = 0; bj < 2; ++bj) { const f32x4 x0 = *(const f32x4*)(x + off + bj * HALF), x1 = *(const f32x4*)(x + off + bj * HALF + 4);
                    const f32x4 v0 = x0 + gv[bj][0] * acc[ai][bj][m][0], v1 = x1 + gv[bj][1] * acc[ai][bj][m][1];
                    u32x4 w; w.x = cvt_pk_bf16(v0[0], v0[1]); w.y = cvt_pk_bf16(v0[2], v0[3]); w.z = cvt_pk_bf16(v1[0], v1[1]); w.w = cvt_pk_bf16(v1[2], v1[3]);
                    *(u32x4*)(out + off + bj * HALF) = w; }
                asm volatile("" ::: "memory"); }
    }
};
struct EpiSwiGLU {
    static constexpr bool PERM = true;
    bf16_t* H;
    __device__ __forceinline__ void operator()(const f32x4 (&acc)[2][2][4][2], const Unit& u, int wr, int wc, int fr, int fq) const {
        const int row0 = u.pm * BM + wr * 64 + fr; const int col0 = u.pn * HALF + wc * 32 + 8 * fq;
#pragma unroll
        for (int ai = 0; ai < 2; ++ai)
#pragma unroll
            for (int m = 0; m < 4; ++m) { bf16_t* rowp = H + (size_t)(row0 + ai * HALF + m * 16) * DE + col0;
                f32x4 h0, h1;
#pragma unroll
                for (int j = 0; j < 4; ++j) { const float g0 = acc[ai][0][m][0][j], g1 = acc[ai][0][m][1][j];
                    h0[j] = g0 * __builtin_amdgcn_rcpf(1.0f + __builtin_amdgcn_exp2f(-1.4426950408889634f * g0)) * acc[ai][1][m][0][j];
                    h1[j] = g1 * __builtin_amdgcn_rcpf(1.0f + __builtin_amdgcn_exp2f(-1.4426950408889634f * g1)) * acc[ai][1][m][1][j]; }
                u32x4 w; w.x = cvt_pk_bf16(h0[0], h0[1]); w.y = cvt_pk_bf16(h0[2], h0[3]); w.z = cvt_pk_bf16(h1[0], h1[1]); w.w = cvt_pk_bf16(h1[2], h1[3]);
                *(u32x4*)rowp = w; }
    }
};
struct EpiSwiGLU8 {
    static constexpr bool PERM = true;
    unsigned char* H;
    const float* wdn; unsigned char* wdq; LAS float* scr; int hbase; mutable int cnt;
    __device__ __forceinline__ void operator()(const f32x4 (&acc)[2][2][4][2], const Unit& u, int wr, int wc, int fr, int fq) const {
        const int row0 = u.pm * BM + wr * 64 + fr; const int col0 = u.pn * HALF + wc * 32 + 8 * fq;
        const int ci = cnt++; const bool conv = wdn != nullptr && (ci & 1) == 0;
        const int lane = (int)__builtin_amdgcn_mbcnt_hi(~0u, __builtin_amdgcn_mbcnt_lo(~0u, 0u));
        f32x4 v[8]; unsigned char* dstp = nullptr;
#pragma unroll
        for (int ai = 0; ai < 2; ++ai) {
            if (ai == 0 && conv) {
                const int h = hbase + (ci >> 1), item = h >> 1, half = h & 1, e = item / (DE / 128 * (D / 32)), r = item % (DE / 128 * (D / 32));
                const int kb = r / (D / 32), nb = r % (D / 32), k0 = 128 * kb + 64 * half, n0 = 32 * nb;
                const float* src = wdn + (size_t)e * DE * D + (size_t)(k0 + (lane >> 3)) * D + n0 + 4 * (lane & 7);
#pragma unroll
                for (int i = 0; i < 8; ++i) v[i] = __builtin_nontemporal_load((const f32x4*)(src + (size_t)(8 * i) * D));
                dstp = wdq + (size_t)e * D * DE + (size_t)(n0 + (lane & 31)) * DE + k0 + 32 * (lane >> 5);
                asm volatile("" ::: "memory");
            }
#pragma unroll
            for (int m = 0; m < 4; ++m) { unsigned char* rowp = H + (size_t)(row0 + ai * HALF + m * 16) * DE + col0;
                f32x4 h0, h1;
#pragma unroll
                for (int j = 0; j < 4; ++j) { const float g0 = acc[ai][0][m][0][j], g1 = acc[ai][0][m][1][j];
                    h0[j] = (1.0f / 256.0f) * g0 * __builtin_amdgcn_rcpf(1.0f + __builtin_amdgcn_exp2f((-1.4426950408889634f / 32.0f) * g0)) * acc[ai][1][m][0][j];
                    h1[j] = (1.0f / 256.0f) * g1 * __builtin_amdgcn_rcpf(1.0f + __builtin_amdgcn_exp2f((-1.4426950408889634f / 32.0f) * g1)) * acc[ai][1][m][1][j]; }
                u32x2 w; w.x = pk4_fp8(h0[0], h0[1], h0[2], h0[3]); w.y = pk4_fp8(h1[0], h1[1], h1[2], h1[3]);
                *(u32x2*)rowp = w; }
        }
        if (conv) {
            asm volatile("" ::: "memory");
            u32x2 w[4];
#pragma unroll
            for (int sstep = 0; sstep < 4; ++sstep) {
#pragma unroll
                for (int q = 0; q < 2; ++q) *(LAS f32x4*)(scr + (8 * q + (lane >> 3)) * 32 + 4 * (lane & 7)) = v[2 * sstep + q];
                LDS_WAIT(); asm volatile("" ::: "memory");
                const LAS float* sp = scr + (8 * (lane >> 5)) * 32 + (lane & 31);
                w[sstep].x = pk4_fp8u(sp[0 * 32] * 64.0f, sp[1 * 32] * 64.0f, sp[2 * 32] * 64.0f, sp[3 * 32] * 64.0f);
                w[sstep].y = pk4_fp8u(sp[4 * 32] * 64.0f, sp[5 * 32] * 64.0f, sp[6 * 32] * 64.0f, sp[7 * 32] * 64.0f);
                LDS_WAIT(); asm volatile("" ::: "memory");
            }
            { auto r0 = __builtin_amdgcn_permlane32_swap(w[0].x, w[2].x, false, false); w[0].x = r0[0]; w[2].x = r0[1];
              auto r1 = __builtin_amdgcn_permlane32_swap(w[0].y, w[2].y, false, false); w[0].y = r1[0]; w[2].y = r1[1];
              auto r2 = __builtin_amdgcn_permlane32_swap(w[1].x, w[3].x, false, false); w[1].x = r2[0]; w[3].x = r2[1];
              auto r3 = __builtin_amdgcn_permlane32_swap(w[1].y, w[3].y, false, false); w[1].y = r3[0]; w[3].y = r3[1]; }
            u32x4 o0, o1; o0.x = w[0].x; o0.y = w[0].y; o0.z = w[2].x; o0.w = w[2].y; o1.x = w[1].x; o1.y = w[1].y; o1.z = w[3].x; o1.w = w[3].y;
            *(u32x4*)dstp = o0; *(u32x4*)(dstp + 16) = o1;
        }
    }
};
struct EpiScaleBf16 {
    static constexpr bool PERM = true;
    unsigned char* Y; const float* gv; float mul;
    __device__ __forceinline__ void operator()(const f32x4 (&acc)[2][2][4][2], const Unit& u, int wr, int wc, int fr, int fq) const {
        const int row0 = u.pm * BM + wr * 64 + fr; const int col0 = u.pn * BM + wc * 32 + 8 * fq;
#pragma unroll
        for (int ai = 0; ai < 2; ++ai)
#pragma unroll
            for (int m = 0; m < 4; ++m) { const int row = row0 + ai * HALF + m * 16; const float s = gv[row] * mul; unsigned char* rowp = Y + (size_t)row * D + col0;
#pragma unroll
                for (int bj = 0; bj < 2; ++bj) { const f32x4 v0 = acc[ai][bj][m][0] * s, v1 = acc[ai][bj][m][1] * s;
                    u32x2 w; w.x = pk4_fp8(v0[0], v0[1], v0[2], v0[3]); w.y = pk4_fp8(v1[0], v1[1], v1[2], v1[3]);
                    *(u32x2*)(rowp + bj * HALF) = w; } }
    }
};


template <class Epi, class Sched, bool GATHER, int EB = 2, bool ALIGN_EPI = true, bool SP2 = true>
__device__ __forceinline__ void gemm_phase(LAS unsigned char* lds, const void* A, const void* Bt, const int Kel, const int* rowid, const Sched& S, const Epi& E) {
    const int K = Kel * EB / 2;
    const int nt = K / BK;
    const int tid = threadIdx.x, wid = __builtin_amdgcn_readfirstlane(tid >> 6), lane = tid & 63, wr = wid >> 2, wc = wid & 3, fr = lane & 15, fq = lane >> 4;
    unsigned voffB[2], cvA[2][2];
#pragma unroll
    for (int i = 0; i < 2; ++i) { int Rr, Cc; stage_rc(tid * 16 + i * 8192, Rr, Cc); const int Rb = Epi::PERM ? ((Rr & ~31) + perm32(Rr & 31)) : Rr;
        voffB[i] = (unsigned)(Rb * K + Cc) * 2u; }
    const size_t kstep = (size_t)(BK * 2);
    const size_t hstep = (size_t)HALF * K * 2;
    const size_t tstep = 2 * hstep;
    const unsigned ldsw = (unsigned)wid * 1024u;
    int aoffk[2], boffk[2];
    aoffk[0] = lds_byte(wr * 64 + fr, fq * 8); aoffk[1] = aoffk[0] + 1024; boffk[0] = lds_byte(wc * 32 + fr, fq * 8); boffk[1] = boffk[0] + 1024;
#define PG8_SA(b, h) (((b) * 2 + (h)) * HTB)
#define PG8_SB(b, h) ((4 + (b) * 2 + (h)) * HTB)
#define PG8_STAGE(bufoff, gbase, voff) do { _Pragma("unroll") for (int _i = 0; _i < 2; ++_i) \
        __builtin_amdgcn_global_load_lds((const unsigned*)((const char*)(gbase) + (voff)[_i]), (LAS unsigned*)(lds + (bufoff) + ldsw + _i * 8192), 16, 0, 0); } while (0)
#define PG8_LDA(dst, b, h) do { _Pragma("unroll") for (int m = 0; m < 4; ++m) _Pragma("unroll") for (int k = 0; k < 2; ++k) dst[m][k] = *(const LAS u32x4*)(lds + PG8_SA(b, h) + aoffk[k] + m * 2048); } while (0)
#define PG8_LDB(dst, b, h) do { _Pragma("unroll") for (int n = 0; n < 2; ++n) _Pragma("unroll") for (int k = 0; k < 2; ++k) dst[n][k] = *(const LAS u32x4*)(lds + PG8_SB(b, h) + boffk[k] + n * 2048); } while (0)
#define PG8_MMA(ai, bj, At, Bt_) do { __builtin_amdgcn_s_setprio(1); _Pragma("unroll") for (int m = 0; m < 4; ++m) _Pragma("unroll") for (int n = 0; n < 2; ++n) { \
        if (EB == 2) { _Pragma("unroll") for (int k = 0; k < 2; ++k) acc[ai][bj][m][n] = __builtin_amdgcn_mfma_f32_16x16x32_bf16(__builtin_bit_cast(bf16x8, Bt_[n][k]), __builtin_bit_cast(bf16x8, At[m][k]), acc[ai][bj][m][n], 0, 0, 0); } \
        else { const v8i32 _b = __builtin_bit_cast(v8i32, __builtin_shufflevector(Bt_[n][0], Bt_[n][1], 0, 1, 2, 3, 4, 5, 6, 7)); \
               const v8i32 _a = __builtin_bit_cast(v8i32, __builtin_shufflevector(At[m][0], At[m][1], 0, 1, 2, 3, 4, 5, 6, 7)); \
               acc[ai][bj][m][n] = __builtin_amdgcn_mfma_scale_f32_16x16x128_f8f6f4(_b, _a, acc[ai][bj][m][n], 0, 0, 0, 0, 0, 0); } } \
        __builtin_amdgcn_s_setprio(0); } while (0)
#define PG8_WAIT_V(n) asm volatile("s_waitcnt vmcnt(" #n ")" ::: "memory")
#define PG8_WAIT_L(n) asm volatile("s_waitcnt lgkmcnt(" #n ")" ::: "memory")
#define PG8_BAR __builtin_amdgcn_s_barrier()
#define PG8_SCHED __builtin_amdgcn_sched_barrier(0)
#define PG8_AOFFS(dst, u) do { _Pragma("unroll") for (int _h = 0; _h < 2; ++_h) _Pragma("unroll") for (int _i = 0; _i < 2; ++_i) { int _R, _C; stage_rc(tid * 16 + _i * 8192, _R, _C); \
        if (GATHER) dst[_h][_i] = (unsigned)rowid[(u).pm * BM + _h * HALF + _R] * (unsigned)(K * 2) + (unsigned)_C * 2u; \
        else dst[_h][_i] = (unsigned)(((u).pm * BM + _h * HALF + _R) * K + _C) * 2u; } } while (0)
    Unit cur, nxt; int ui = 0;
    if (!S.next(0, cur)) return;
    f32x4 acc[2][2][4][2];
#pragma unroll
    for (int a = 0; a < 2; ++a)
#pragma unroll
        for (int b = 0; b < 2; ++b)
#pragma unroll
            for (int m = 0; m < 4; ++m)
#pragma unroll
                for (int n = 0; n < 2; ++n) acc[a][b][m][n] = (f32x4){0.f, 0.f, 0.f, 0.f};
    u32x4 At[4][2], B0[2][2], B1[2][2];
    const char* cA = (const char*)A; const char* cB = (const char*)Bt + (size_t)cur.pb * tstep;
    PG8_AOFFS(cvA, cur);
    if constexpr (SP2) {
        PG8_STAGE(PG8_SB(0, 0), cB, voffB); PG8_STAGE(PG8_SB(0, 1), cB + hstep, voffB); PG8_STAGE(PG8_SA(0, 0), cA, cvA[0]); PG8_STAGE(PG8_SA(0, 1), cA, cvA[1]);
        if (wr == 1) PG8_BAR;
        PG8_WAIT_V(2); PG8_BAR;
        PG8_STAGE(PG8_SB(1, 0), cB + kstep, voffB); PG8_STAGE(PG8_SA(1, 0), cA + kstep, cvA[0]); PG8_STAGE(PG8_SB(1, 1), cB + hstep + kstep, voffB);
        PG8_WAIT_V(6); PG8_BAR;
    } else {
        PG8_STAGE(PG8_SB(0, 0), cB, voffB); PG8_STAGE(PG8_SA(0, 0), cA, cvA[0]); PG8_STAGE(PG8_SB(0, 1), cB + hstep, voffB); PG8_STAGE(PG8_SA(0, 1), cA, cvA[1]);
        if (wr == 1) PG8_BAR;
        PG8_WAIT_V(4); PG8_BAR;
        PG8_STAGE(PG8_SB(1, 0), cB + kstep, voffB); PG8_STAGE(PG8_SA(1, 0), cA + kstep, cvA[0]); PG8_STAGE(PG8_SB(1, 1), cB + hstep + kstep, voffB);
        PG8_WAIT_V(6); PG8_BAR;
    }
    for (;;) {
        const bool has_next = S.next(ui + 1, nxt);
        const char* nA = cA; const char* nB = has_next ? (const char*)Bt + (size_t)nxt.pb * tstep : cB;
        for (int t = 0; t < nt; t += 2) {
            const bool last = (t == nt - 2);
            asm volatile("" : "+v"(cvA[0][0]), "+v"(cvA[0][1]), "+v"(cvA[1][0]), "+v"(cvA[1][1]), "+v"(voffB[0]), "+v"(voffB[1]));
            const char* a1 = cA + (size_t)(t + 1) * kstep;
            const char* a2 = last ? nA : cA + (size_t)(t + 2) * kstep; const char* b2 = last ? nB : cB + (size_t)(t + 2) * kstep;
            const char* a3 = a2 + kstep; const char* b3 = b2 + kstep;
            if constexpr (SP2) {
            PG8_LDB(B0, 0, 0); PG8_LDB(B1, 0, 1); PG8_SCHED; PG8_LDA(At, 0, 0); PG8_STAGE(PG8_SA(1, 1), a1, cvA[1]);
            if (last && has_next) { PG8_AOFFS(cvA, nxt); }
            PG8_WAIT_V(8); PG8_WAIT_L(0); PG8_BAR; PG8_MMA(0, 0, At, B0); PG8_MMA(0, 1, At, B1); PG8_BAR; PG8_SCHED;
            PG8_LDA(At, 0, 1); PG8_STAGE(PG8_SB(0, 0), b2, voffB); PG8_STAGE(PG8_SB(0, 1), b2 + hstep, voffB); PG8_STAGE(PG8_SA(0, 0), a2, cvA[0]);
            PG8_WAIT_V(8); PG8_WAIT_L(0); PG8_BAR; PG8_MMA(1, 0, At, B0); PG8_MMA(1, 1, At, B1); PG8_BAR; PG8_SCHED;
            PG8_LDB(B0, 1, 0); PG8_LDB(B1, 1, 1); PG8_SCHED; PG8_LDA(At, 1, 0); PG8_STAGE(PG8_SA(0, 1), a2, cvA[1]);
            PG8_WAIT_V(8); PG8_WAIT_L(0); PG8_BAR; PG8_MMA(0, 0, At, B0); PG8_MMA(0, 1, At, B1); PG8_BAR; PG8_SCHED;
            PG8_LDA(At, 1, 1); PG8_STAGE(PG8_SB(1, 0), b3, voffB); PG8_STAGE(PG8_SB(1, 1), b3 + hstep, voffB); PG8_STAGE(PG8_SA(1, 0), a3, cvA[0]);
            PG8_WAIT_V(8); PG8_WAIT_L(0); PG8_BAR; PG8_MMA(1, 0, At, B0); PG8_MMA(1, 1, At, B1); PG8_BAR; PG8_SCHED;
            } else {
            PG8_LDB(B0, 0, 0); PG8_SCHED; PG8_LDA(At, 0, 0); PG8_STAGE(PG8_SA(1, 1), a1, cvA[1]);
            if (last && has_next) { PG8_AOFFS(cvA, nxt); }
            PG8_WAIT_L(8); PG8_BAR; PG8_WAIT_L(0); PG8_MMA(0, 0, At, B0); PG8_BAR; PG8_SCHED;
            PG8_LDB(B1, 0, 1); PG8_STAGE(PG8_SB(0, 0), b2, voffB);
            PG8_BAR; PG8_WAIT_L(0); PG8_MMA(0, 1, At, B1); PG8_BAR;
            PG8_LDA(At, 0, 1); PG8_STAGE(PG8_SA(0, 0), a2, cvA[0]);
            PG8_BAR; PG8_WAIT_L(0); PG8_MMA(1, 0, At, B0); PG8_BAR; PG8_SCHED;
            PG8_STAGE(PG8_SB(0, 1), b2 + hstep, voffB);
            PG8_WAIT_V(6); PG8_BAR; PG8_MMA(1, 1, At, B1); PG8_BAR;
            PG8_LDB(B0, 1, 0); PG8_SCHED; PG8_LDA(At, 1, 0); PG8_STAGE(PG8_SA(0, 1), a2, cvA[1]);
            PG8_WAIT_L(8); PG8_BAR; PG8_WAIT_L(0); PG8_MMA(0, 0, At, B0); PG8_BAR; PG8_SCHED;
            PG8_LDB(B1, 1, 1); PG8_STAGE(PG8_SB(1, 0), b3, voffB);
            PG8_BAR; PG8_WAIT_L(0); PG8_MMA(0, 1, At, B1); PG8_BAR;
            PG8_LDA(At, 1, 1); PG8_STAGE(PG8_SA(1, 0), a3, cvA[0]);
            PG8_BAR; PG8_WAIT_L(0); PG8_MMA(1, 0, At, B0); PG8_BAR; PG8_SCHED;
            PG8_STAGE(PG8_SB(1, 1), b3 + hstep, voffB);
            PG8_WAIT_V(6); PG8_BAR; PG8_MMA(1, 1, At, B1); PG8_BAR;
            }
        }
        if constexpr (ALIGN_EPI) { if (wr == 0) PG8_BAR; }
        E(acc, cur, wr, wc, fr, fq);
        if (!has_next) break;
#pragma unroll
        for (int a = 0; a < 2; ++a)
#pragma unroll
            for (int b = 0; b < 2; ++b)
#pragma unroll
                for (int m = 0; m < 4; ++m)
#pragma unroll
                    for (int n = 0; n < 2; ++n) acc[a][b][m][n] = (f32x4){0.f, 0.f, 0.f, 0.f};
        cur = nxt; cA = nA; cB = nB; ++ui;
        if constexpr (ALIGN_EPI) { if (wr == 1) PG8_BAR; }
    }
    PG8_WAIT_V(0);
    if constexpr (!ALIGN_EPI) { if (wr == 0) PG8_BAR; }
    PG8_BAR;
#undef PG8_SA
#undef PG8_SB
#undef PG8_STAGE
#undef PG8_LDA
#undef PG8_LDB
#undef PG8_MMA
#undef PG8_WAIT_V
#undef PG8_WAIT_L
#undef PG8_BAR
#undef PG8_SCHED
#undef PG8_AOFFS
}
}


#define CROW(r, hh) (((r) & 3) + 8 * ((r) >> 2) + 4 * (hh))
__device__ __forceinline__ float xhalf(float x, int hh) {
    const unsigned u = __builtin_bit_cast(unsigned, x); const auto rr = __builtin_amdgcn_permlane32_swap(u, u, false, false);
    return __builtin_bit_cast(float, hh ? rr[0] : rr[1]); }
template <int PASS>
__device__ __forceinline__ void lru_item(const LAS unsigned char* WL, LAS unsigned char* xct, const bf16_t* PB, bf16_t* MIX, f32x2* CAGG,
        const float* convw, const float* convb, const float* ba, const float* bi, const float* lamp, const int n, const int b, const int chunk, const int lane, const float hc0, const float hc1) {
    const int r32 = lane & 31, hh = lane >> 5;
    const bool isctx = chunk < 4; const int t0 = isctx ? chunk * 64 : (chunk - 4) * 64; const int L = isctx ? CTX : SEQ;
    const size_t rowbase = isctx ? (size_t)(ML + b * CTX) : (size_t)(b * SEQ);
    {
        const int c8 = lane & 7, rg = lane >> 3; const int ch = n * 64 + 8 * c8;
        const bf16_t* xp = PB + rowbase * INW + ch; const int tb0 = t0 + 8 * rg - 1;
        u32x4 raw[11];
#pragma unroll
        for (int i = 0; i < 11; ++i) { const int tt = tb0 + i; raw[i] = (tt >= 0 && tt < L) ? *(const u32x4*)(xp + (size_t)tt * INW) : (u32x4){0u, 0u, 0u, 0u}; }
        f32x4 wlo[4], whi[4];
#pragma unroll
        for (int k = 0; k < 4; ++k) { wlo[k] = *(const f32x4*)(convw + k * 512 + ch); whi[k] = *(const f32x4*)(convw + k * 512 + ch + 4); }
        const f32x4 blo = *(const f32x4*)(convb + ch), bhi = *(const f32x4*)(convb + ch + 4);
#pragma unroll
        for (int tk = 0; tk < 8; ++tk) {
            f32x4 ylo = blo, yhi = bhi;
#pragma unroll
            for (int k = 0; k < 4; ++k) { const u32x4 rw = raw[tk + k];
                ylo += wlo[k] * (f32x4){bflo(rw.x), bfhi(rw.x), bflo(rw.y), bfhi(rw.y)}; yhi += whi[k] * (f32x4){bflo(rw.z), bfhi(rw.z), bflo(rw.w), bfhi(rw.w)}; }
            u32x4 o; o.x = pk2(ylo.x, ylo.y); o.y = pk2(ylo.z, ylo.w); o.z = pk2(yhi.x, yhi.y); o.w = pk2(yhi.z, yhi.w);
            *(LAS u32x4*)(xct + (8 * rg + tk) * 144 + c8 * 16) = o; }
    }
    LDS_WAIT(); asm volatile("" ::: "memory");
    bf16x8 af[2][4];
#pragma unroll
    for (int tb = 0; tb < 2; ++tb)
#pragma unroll
        for (int ks = 0; ks < 4; ++ks) af[tb][ks] = *(const LAS bf16x8*)(xct + (32 * tb + r32) * 144 + ks * 32 + hh * 16);
#pragma unroll 1
    for (int vb = 0; vb < 2; ++vb) {
        const int ch = n * 64 + 32 * vb + r32;
        float hsum[2][16];
#pragma unroll
        for (int d = 0; d < 2; ++d) {
            f32x16 ga[2], gi[2];
#pragma unroll
            for (int tb = 0; tb < 2; ++tb)
#pragma unroll
                for (int r = 0; r < 16; ++r) { ga[tb][r] = 0.f; gi[tb][r] = 0.f; }
#pragma unroll
            for (int ks = 0; ks < 4; ++ks) {
                const bf16x8 wa = *(const LAS bf16x8*)(WL + ((2 * d) * 64 + 32 * vb + r32) * 144 + ks * 32 + hh * 16);
                const bf16x8 wi = *(const LAS bf16x8*)(WL + ((2 * d + 1) * 64 + 32 * vb + r32) * 144 + ks * 32 + hh * 16);
#pragma unroll
                for (int tb = 0; tb < 2; ++tb) { ga[tb] = __builtin_amdgcn_mfma_f32_32x32x16_bf16(af[tb][ks], wa, ga[tb], 0, 0, 0); gi[tb] = __builtin_amdgcn_mfma_f32_32x32x16_bf16(af[tb][ks], wi, gi[tb], 0, 0, 0); }
            }
            const float nba = -1.4426950408889634f * ba[d * 512 + ch], nbi = -1.4426950408889634f * bi[d * 512 + ch]; const float sp8l = -8.0f * 1.4426950408889634f * log1pf(__expf(-lamp[d * 512 + ch]));
            const bool has_reset = isctx && (d == 0 ? (chunk == 0) : (chunk == 3));
#pragma unroll
            for (int tb = 0; tb < 2; ++tb)
#pragma unroll
                for (int r = 0; r < 16; ++r) { const int tl = 32 * tb + CROW(r, hh);
                    const float xcv = bf2f(*(const LAS bf16_t*)(xct + tl * 144 + (32 * vb + r32) * 2));
                    const float rr = __builtin_amdgcn_rcpf(1.0f + __builtin_amdgcn_exp2f(__builtin_fmaf(ga[tb][r], -1.4426950408889634f, nba)));
                    const float ii = __builtin_amdgcn_rcpf(1.0f + __builtin_amdgcn_exp2f(__builtin_fmaf(gi[tb][r], -1.4426950408889634f, nbi)));
                    const float a = __builtin_amdgcn_exp2f(rr * sp8l);
                    float mult = __builtin_amdgcn_sqrtf(fmaxf(__builtin_fmaf(-a, a, 1.0f), 0.f));
                    if ((d == 0 && tb == 0 && r == 0) || (d == 1 && tb == 1 && r == 15)) { if (has_reset && hh == d) mult = 1.0f; }
                    ga[tb][r] = a; gi[tb][r] = mult * (ii * xcv); }
#pragma unroll
            for (int tb = 0; tb < 2; ++tb)
#pragma unroll
                for (int g = 0; g < 4; ++g) {
                    if (d == 0) {
#pragma unroll
                        for (int i = 1; i < 4; ++i) { gi[tb][4 * g + i] = ga[tb][4 * g + i] * gi[tb][4 * g + i - 1] + gi[tb][4 * g + i]; ga[tb][4 * g + i] *= ga[tb][4 * g + i - 1]; }
                    } else {
#pragma unroll
                        for (int i = 2; i >= 0; --i) { gi[tb][4 * g + i] = ga[tb][4 * g + i] * gi[tb][4 * g + i + 1] + gi[tb][4 * g + i]; ga[tb][4 * g + i] *= ga[tb][4 * g + i + 1]; }
                    }
                }
            const int e4 = (d == 0) ? 3 : 0;
            float A0[8], U0[8], A1[8], U1[8];
#pragma unroll
            for (int q = 0; q < 8; ++q) { const float mA = ga[q >> 2][4 * (q & 3) + e4], mU = gi[q >> 2][4 * (q & 3) + e4];
                const float pA = xhalf(mA, hh), pU = xhalf(mU, hh);
                A0[q] = hh ? pA : mA; U0[q] = hh ? pU : mU; A1[q] = hh ? mA : pA; U1[q] = hh ? mU : pU; }
            float hin[8];
            if (PASS == 0) {
                float Ast = 1.0f, Ust = 0.0f;
#pragma unroll
                for (int qq = 0; qq < 8; ++qq) { const int q = (d == 0) ? qq : 7 - qq;
                    if (d == 0) { Ust = A0[q] * Ust + U0[q]; Ast *= A0[q]; Ust = A1[q] * Ust + U1[q]; Ast *= A1[q]; }
                    else        { Ust = A1[q] * Ust + U1[q]; Ast *= A1[q]; Ust = A0[q] * Ust + U0[q]; Ast *= A0[q]; } }
                if (hh == 0) CAGG[((size_t)(b * 68 + chunk) * 2 + d) * 512 + ch] = (f32x2){Ast, Ust};
            } else {
                float hst = __shfl(d == 0 ? hc0 : hc1, 32 * vb + r32);
#pragma unroll
                for (int qq = 0; qq < 8; ++qq) { const int q = (d == 0) ? qq : 7 - qq;
                    if (d == 0) { const float mid = A0[q] * hst + U0[q]; hin[q] = hh ? mid : hst; hst = A1[q] * mid + U1[q]; }
                    else        { const float mid = A1[q] * hst + U1[q]; hin[q] = hh ? hst : mid; hst = A0[q] * mid + U0[q]; } }
#pragma unroll
                for (int tb = 0; tb < 2; ++tb)
#pragma unroll
                    for (int r = 0; r < 16; ++r) { const float hv = ga[tb][r] * hin[tb * 4 + (r >> 2)] + gi[tb][r]; hsum[tb][r] = (d == 0) ? hv : hsum[tb][r] + hv; }
            }
        }
        if (PASS == 1) {
#pragma unroll
            for (int tb = 0; tb < 2; ++tb)
#pragma unroll
                for (int r = 0; r < 16; ++r) *(LAS bf16_t*)(xct + (32 * tb + CROW(r, hh)) * 144 + (32 * vb + r32) * 2) = (bf16_t)f2bf(hsum[tb][r]);
        }
    }
    if (PASS == 1) {
        LDS_WAIT(); asm volatile("" ::: "memory");
        const int rr0 = lane >> 3, cg = lane & 7;
#pragma unroll 2
        for (int it = 0; it < 8; ++it) { const int tl = it * 8 + rr0; const size_t row = rowbase + t0 + tl;
            const u32x4 hv = *(const LAS u32x4*)(xct + tl * 144 + cg * 16); const u32x4 gv = *(const u32x4*)(PB + row * INW + 512 + n * 64 + cg * 8);
            u32x4 o;
            o.x = pk2(bflo(hv.x) * gelu_tanh(bflo(gv.x)), bfhi(hv.x) * gelu_tanh(bfhi(gv.x))); o.y = pk2(bflo(hv.y) * gelu_tanh(bflo(gv.y)), bfhi(hv.y) * gelu_tanh(bfhi(gv.y)));
            o.z = pk2(bflo(hv.z) * gelu_tanh(bflo(gv.z)), bfhi(hv.z) * gelu_tanh(bfhi(gv.z))); o.w = pk2(bflo(hv.w) * gelu_tanh(bflo(gv.w)), bfhi(hv.w) * gelu_tanh(bfhi(gv.w)));
            *(u32x4*)(MIX + row * D + n * 64 + cg * 8) = o; }
    }
    LDS_WAIT(); asm volatile("" ::: "memory");
}
__device__ __forceinline__ void lru_load_weights(LAS unsigned char* WL, const float* wa, const float* wi, int n, int tid) {
    for (int i = tid; i < 4 * 4096; i += NTHREADS) { const int mat = i >> 12, w = (i >> 6) & 63, v = i & 63; const int d = mat >> 1;
        const float* src = (mat & 1) ? wi : wa; const float x = src[((size_t)(d * 8 + n) * 64 + w) * 64 + v];
        *(LAS bf16_t*)(WL + (mat * 64 + v) * 144 + w * 2) = (bf16_t)f2bf(x); }
}


__device__ __forceinline__ void att8_phase(LAS unsigned char* lds, const unsigned char* QN8, const unsigned char* KN8, const unsigned char* VT8, bf16_t* MIX, const float* subg, const float lam,
                                           const int vcu, const int G, const int tid, const int lane, const int wave) {
    constexpr int KP = 144, VP = 80, KBYTES = 64 * KP, ABUF = KBYTES + 128 * VP;
    const int r32 = lane & 31, hh = lane >> 5, cc = wave >> 2, wq = wave & 3;
    for (int uu = vcu; uu < NB * 4 * 32; uu += G) {
        const int qb = uu & 31, h = (uu >> 5) & 3, b = uu >> 7;
        const int q0 = qb * 128 + wq * 32;
        v8i32 qf;
        { const unsigned char* qp = QN8 + ((size_t)((b * 4 + h) * SEQ + q0 + r32) * 128 + cc * 64 + hh * 32);
          const u32x4 qa = *(const u32x4*)qp, qb2 = *(const u32x4*)(qp + 16); qf = __builtin_bit_cast(v8i32, __builtin_shufflevector(qa, qb2, 0, 1, 2, 3, 4, 5, 6, 7)); }
        const unsigned char* kbase = KN8 + (size_t)((b * 4 + h) * 4352) * 128 + tid * 16;
        const unsigned char* vbase = VT8 + (size_t)((b * 4 + h) * 128 + (tid >> 2)) * 4352 + (tid & 3) * 16;
        const int kst = (tid >> 3) * KP + (tid & 7) * 16, vst = KBYTES + (tid >> 2) * VP + (tid & 3) * 16;
        u32x4 kr, vr;
        v8i32 ones8;
#pragma unroll
        for (int i = 0; i < 8; ++i) ones8[i] = 0x38383838;
        asm volatile("" : "+v"(ones8));
#define ATT_LOAD(t) do { kr = *(const u32x4*)(kbase + (size_t)(t) * 8192); vr = *(const u32x4*)(vbase + (t) * 64); } while (0)
#define ATT_STORE(bufo) do { *(LAS u32x4*)(lds + (bufo) + kst) = kr; *(LAS u32x4*)(lds + (bufo) + vst) = vr; } while (0)
        ATT_LOAD(0); ATT_STORE(0);
        __syncthreads();
        f32x16 o[4];
#pragma unroll
        for (int eb = 0; eb < 4; ++eb)
#pragma unroll
            for (int r = 0; r < 16; ++r) o[eb][r] = 0.f;
        f32x16 lacc;
#pragma unroll
        for (int r = 0; r < 16; ++r) lacc[r] = 0.f;
        for (int t = 0; t < 68; ++t) {
            const int bufo = (t & 1) * ABUF;
            if (t + 1 < 68) ATT_LOAD(t + 1);
            const LAS unsigned char* kl = lds + bufo + r32 * KP + cc * 64 + hh * 32;
            const v8i32 kf0 = __builtin_bit_cast(v8i32, __builtin_shufflevector(*(const LAS u32x4*)kl, *(const LAS u32x4*)(kl + 16), 0, 1, 2, 3, 4, 5, 6, 7));
            const v8i32 kf1 = __builtin_bit_cast(v8i32, __builtin_shufflevector(*(const LAS u32x4*)(kl + 32 * KP), *(const LAS u32x4*)(kl + 32 * KP + 16), 0, 1, 2, 3, 4, 5, 6, 7));
            f32x16 s0, s1;
#pragma unroll
            for (int r = 0; r < 16; ++r) { s0[r] = 0.f; s1[r] = 0.f; }
            s0 = __builtin_amdgcn_mfma_scale_f32_32x32x64_f8f6f4(kf0, qf, s0, 0, 0, 0, 0, 0, 0);
            s1 = __builtin_amdgcn_mfma_scale_f32_32x32x64_f8f6f4(kf1, qf, s1, 0, 0, 0, 0, 0, 0);
#pragma unroll
            for (int r = 0; r < 16; ++r) { s0[r] = __builtin_amdgcn_exp2f(s0[r]); s1[r] = __builtin_amdgcn_exp2f(s1[r]); }
            v8i32 pa;
#pragma unroll
            for (int w = 0; w < 4; ++w) {
                int x; asm volatile("" : "=v"(x)); x = __builtin_amdgcn_cvt_pk_bf8_f32(s0[4 * w], s0[4 * w + 1], x, false); x = __builtin_amdgcn_cvt_pk_bf8_f32(s0[4 * w + 2], s0[4 * w + 3], x, true); pa[w] = x;
                int y; asm volatile("" : "=v"(y)); y = __builtin_amdgcn_cvt_pk_bf8_f32(s1[4 * w], s1[4 * w + 1], y, false); y = __builtin_amdgcn_cvt_pk_bf8_f32(s1[4 * w + 2], s1[4 * w + 3], y, true); pa[4 + w] = y; }
            lacc = __builtin_amdgcn_mfma_scale_f32_32x32x64_f8f6f4(pa, ones8, lacc, 1, 0, 0, 0, 0, 0);
            const LAS unsigned char* vl = lds + bufo + KBYTES + r32 * VP + hh * 32;
#pragma unroll
            for (int eb = 0; eb < 4; ++eb) {
                const v8i32 vf = __builtin_bit_cast(v8i32, __builtin_shufflevector(*(const LAS u32x4*)(vl + eb * 32 * VP), *(const LAS u32x4*)(vl + eb * 32 * VP + 16), 0, 1, 2, 3, 4, 5, 6, 7));
                o[eb] = __builtin_amdgcn_mfma_scale_f32_32x32x64_f8f6f4(pa, vf, o[eb], 1, 0, 0, 0, 0, 0); }
            if (t + 1 < 68) ATT_STORE(((t + 1) & 1) * ABUF);
            __syncthreads();
        }
#undef ATT_LOAD
#undef ATT_STORE
        LAS float* ex = (LAS float*)lds + wq * 4096;
        float rl[16];
#pragma unroll
        for (int r = 0; r < 16; ++r) rl[r] = __builtin_amdgcn_rcpf(lacc[r]);
        if (cc == 1) {
#pragma unroll
            for (int eb = 0; eb < 4; ++eb)
#pragma unroll
                for (int r = 0; r < 16; ++r) ex[((r & 3) + 8 * (r >> 2) + 4 * hh) * 128 + eb * 32 + r32] = o[eb][r] * rl[r];
        }
        __syncthreads();
        if (cc == 0) {
            float ss[16];
#pragma unroll
            for (int r = 0; r < 16; ++r) ss[r] = 0.f;
#pragma unroll
            for (int eb = 0; eb < 4; ++eb)
#pragma unroll
                for (int r = 0; r < 16; ++r) { const float a = o[eb][r] * rl[r] - lam * ex[((r & 3) + 8 * (r >> 2) + 4 * hh) * 128 + eb * 32 + r32]; o[eb][r] = a; ss[r] += a * a; }
#pragma unroll
            for (int r = 0; r < 16; ++r) { float v = ss[r];
#pragma unroll
                for (int of = 1; of < 32; of <<= 1) v += __shfl_xor(v, of);
                ss[r] = (1.0f - LAM_INIT) * __builtin_amdgcn_rsqf(v * (1.0f / 128.0f) + EPS); }
#pragma unroll
            for (int eb = 0; eb < 4; ++eb) { const float g = subg[eb * 32 + r32];
#pragma unroll
                for (int r = 0; r < 16; ++r) MIX[(size_t)(b * SEQ + q0 + (r & 3) + 8 * (r >> 2) + 4 * hh) * D + 512 + h * 128 + eb * 32 + r32] = (bf16_t)f2bf(o[eb][r] * ss[r] * g); }
        }
        __syncthreads();
    }
}

struct Args {
    const float* in[28]; float* out; unsigned char* ws; int ph_lo, ph_hi, li, pad;
};
enum { I_X = 0, I_C, I_CTX, I_CCTX, I_WADA, I_BADA, I_N1G, I_N2G, I_WIN, I_CONVW, I_CONVB, I_WA, I_BA, I_WI, I_BI, I_LAM, I_QG, I_KG, I_LQ1, I_LK1, I_LQ2, I_LK2, I_SUBG, I_WOUT, I_WR, I_WG, I_WU, I_WDN };

template <bool F8>
__device__ __forceinline__ void transpose_item(const float* W, int K, int N, void* WTv, int mode, LAS float* scr, int item, int lane, float wscale = 1.0f, int ncols = 0) {
    const int nblk = (ncols ? ncols : N) / 32, kb = item / nblk, nb = item % nblk, k0 = 64 * kb, n0 = 32 * nb;
#pragma unroll 8
    for (int i = 0; i < 32; ++i) { const int kk = 2 * i + (lane >> 5); scr[kk * 33 + (lane & 31)] = W[(size_t)(k0 + kk) * N + n0 + (lane & 31)]; }
    LDS_WAIT(); asm volatile("" ::: "memory");
    const int c = lane & 7;
    const int r0 = (mode == 0) ? n0 : ((n0 >> 7) * 256 + (n0 & 127) + (mode == 2 ? 128 : 0));
#pragma unroll
    for (int j = 0; j < 4; ++j) { const int n = (lane >> 3) + 8 * j; const LAS float* sp = scr + (8 * c) * 33 + n;
        if (F8) { u32x2 o; o.x = pk4_fp8(sp[0 * 33] * wscale, sp[1 * 33] * wscale, sp[2 * 33] * wscale, sp[3 * 33] * wscale); o.y = pk4_fp8(sp[4 * 33] * wscale, sp[5 * 33] * wscale, sp[6 * 33] * wscale, sp[7 * 33] * wscale);
            *(u32x2*)((unsigned char*)WTv + (size_t)(r0 + n) * K + k0 + 8 * c) = o; }
        else { u32x4 o; o.x = pk2(sp[0 * 33], sp[1 * 33]); o.y = pk2(sp[2 * 33], sp[3 * 33]); o.z = pk2(sp[4 * 33], sp[5 * 33]); o.w = pk2(sp[6 * 33], sp[7 * 33]);
            *(u32x4*)((bf16_t*)WTv + (size_t)(r0 + n) * K + k0 + 8 * c) = o; } }
    LDS_WAIT(); asm volatile("" ::: "memory");
}

__device__ __forceinline__ void transpose_item_f8(const float* W, int K, int N, unsigned char* WT, int mode, LAS float* scr, int item, int lane, float wscale) {
    const int nblk = N / 32, kb = item / nblk, nb = item % nblk, k0 = 128 * kb, n0 = 32 * nb;
    const int kr = lane >> 3, n4 = lane & 7;
    f32x4 v[16];
    const float* src = W + (size_t)(k0 + kr) * N + n0 + 4 * n4;
#pragma unroll
    for (int i = 0; i < 16; ++i) v[i] = __builtin_nontemporal_load((const f32x4*)(src + (size_t)(8 * i) * N));
#pragma unroll
    for (int i = 0; i < 16; ++i) { const int k = 8 * i + kr; *(LAS f32x4*)(scr + k * 32 + 4 * (n4 ^ (k >> 4))) = v[i]; }
    LDS_WAIT(); asm volatile("" ::: "memory");
    const int kg = lane & 7;
    const int r0 = (mode == 0) ? n0 : ((n0 >> 7) * 256 + (n0 & 127) + (mode == 2 ? 128 : 0));
#pragma unroll
    for (int j = 0; j < 4; ++j) { const int n = (lane >> 3) + 8 * j; const LAS float* sp = scr + (16 * kg) * 32 + (((n >> 2) ^ kg) << 2) + (n & 3);
        u32x4 o;
        o.x = pk4_fp8u(sp[0 * 32] * wscale, sp[1 * 32] * wscale, sp[2 * 32] * wscale, sp[3 * 32] * wscale); o.y = pk4_fp8u(sp[4 * 32] * wscale, sp[5 * 32] * wscale, sp[6 * 32] * wscale, sp[7 * 32] * wscale);
        o.z = pk4_fp8u(sp[8 * 32] * wscale, sp[9 * 32] * wscale, sp[10 * 32] * wscale, sp[11 * 32] * wscale); o.w = pk4_fp8u(sp[12 * 32] * wscale, sp[13 * 32] * wscale, sp[14 * 32] * wscale, sp[15 * 32] * wscale);
        *(u32x4*)(WT + (size_t)(r0 + n) * K + k0 + 16 * kg) = o; }
    LDS_WAIT(); asm volatile("" ::: "memory");
}

__device__ __forceinline__ void transpose_item_f8h(const float* W, int K, int N, unsigned char* WT, int mode, LAS float* scr, int item, int half, int lane, float wscale) {
    const int nblk = N / 32, kb = item / nblk, nb = item % nblk, k0 = 128 * kb + 64 * half, n0 = 32 * nb;
    const int kr = lane >> 3, n4 = lane & 7;
    f32x4 v[8];
    const float* src = W + (size_t)(k0 + kr) * N + n0 + 4 * n4;
#pragma unroll
    for (int i = 0; i < 8; ++i) v[i] = __builtin_nontemporal_load((const f32x4*)(src + (size_t)(8 * i) * N));
#pragma unroll
    for (int i = 0; i < 8; ++i) { const int k = 8 * i + kr; *(LAS f32x4*)(scr + k * 32 + 4 * (n4 ^ (2 * (k >> 4)))) = v[i]; }
    LDS_WAIT(); asm volatile("" ::: "memory");
    const int kg = lane & 3;
    const int r0 = (mode == 0) ? n0 : ((n0 >> 7) * 256 + (n0 & 127) + (mode == 2 ? 128 : 0));
#pragma unroll
    for (int j = 0; j < 2; ++j) { const int n = (lane >> 2) + 16 * j; const LAS float* sp = scr + (16 * kg) * 32 + (((n >> 2) ^ (2 * kg)) << 2) + (n & 3);
        u32x4 o;
        o.x = pk4_fp8u(sp[0 * 32] * wscale, sp[1 * 32] * wscale, sp[2 * 32] * wscale, sp[3 * 32] * wscale); o.y = pk4_fp8u(sp[4 * 32] * wscale, sp[5 * 32] * wscale, sp[6 * 32] * wscale, sp[7 * 32] * wscale);
        o.z = pk4_fp8u(sp[8 * 32] * wscale, sp[9 * 32] * wscale, sp[10 * 32] * wscale, sp[11 * 32] * wscale); o.w = pk4_fp8u(sp[12 * 32] * wscale, sp[13 * 32] * wscale, sp[14 * 32] * wscale, sp[15 * 32] * wscale);
        *(u32x4*)(WT + (size_t)(r0 + n) * K + k0 + 16 * kg) = o; }
    LDS_WAIT(); asm volatile("" ::: "memory");
}
constexpr int CONV_IG = (D / 128) * (DE / 32)  , CONV_ID = (DE / 128) * (D / 32)  , CONV_NIT = NE * (2 * CONV_IG + CONV_ID)  ;
constexpr int CONV_P2 = 24;
constexpr int CONV_P3 = 4, CONV_N3 = 1792 * CONV_P3;
constexpr int CONV_NGU = NE * 2 * CONV_IG  ;
constexpr int CONV_NP8 = CONV_NGU - 208 * CONV_P2 - CONV_N3;
__device__ __forceinline__ int gu_it(int g) { return (g / (2 * CONV_IG)) * (2 * CONV_IG + CONV_ID) + g % (2 * CONV_IG); }
__device__ __forceinline__ void conv_item(const Args& args, unsigned char* WGUQ, unsigned char* WDQ, LAS float* scr, int it, int lane) {
    const int e = it / (2 * CONV_IG + CONV_ID); int r = it % (2 * CONV_IG + CONV_ID);
    if (r < CONV_IG) { transpose_item_f8(args.in[I_WG] + (size_t)e * D * DE, D, DE, WGUQ + (size_t)e * GU_N * D, 1, scr, r, lane, 32.0f); return; } r -= CONV_IG;
    if (r < CONV_IG) { transpose_item_f8(args.in[I_WU] + (size_t)e * D * DE, D, DE, WGUQ + (size_t)e * GU_N * D, 2, scr, r, lane, 32.0f); return; } r -= CONV_IG;
    transpose_item_f8(args.in[I_WDN] + (size_t)e * DE * D, DE, D, WDQ + (size_t)e * D * DE, 0, scr, r, lane, 64.0f);
}
__device__ __forceinline__ void conv_item_half(const Args& args, unsigned char* WGUQ, unsigned char* WDQ, LAS float* scr, int it, int half, int lane) {
    const int e = it / (2 * CONV_IG + CONV_ID); int r = it % (2 * CONV_IG + CONV_ID);
    if (r < CONV_IG) { transpose_item_f8h(args.in[I_WG] + (size_t)e * D * DE, D, DE, WGUQ + (size_t)e * GU_N * D, 1, scr, r, half, lane, 32.0f); return; } r -= CONV_IG;
    if (r < CONV_IG) { transpose_item_f8h(args.in[I_WU] + (size_t)e * D * DE, D, DE, WGUQ + (size_t)e * GU_N * D, 2, scr, r, half, lane, 32.0f); return; } r -= CONV_IG;
    transpose_item_f8h(args.in[I_WDN] + (size_t)e * DE * D, DE, D, WDQ + (size_t)e * D * DE, 0, scr, r, half, lane, 64.0f);
}

__global__ void __launch_bounds__(NTHREADS, 2) mk_fwd(Args args) {
    extern __shared__ __attribute__((aligned(16))) unsigned char lds_raw[];
    LAS unsigned char* lds = (LAS unsigned char*)lds_raw;
    volatile LAS unsigned* MISC = (volatile LAS unsigned*)(lds + MISC_OFF);
    const int tid = threadIdx.x, lane = tid & 63, wave = __builtin_amdgcn_readfirstlane(tid >> 6);
    const int G = gridDim.x; const int bx = blockIdx.x;
    const int vcu = (G % 8 == 0) ? (bx % 8) * (G / 8) + bx / 8 : bx;
    const int gw = vcu * NWAVES + wave, NGW = G * NWAVES;
    unsigned char* ws = args.ws;
    unsigned* ctl = (unsigned*)(ws + WS_CTL);
    float* MODP = (float*)(ws + WS_MODP); float* MOD = (float*)(ws + WS_MOD); float* SCAL = (float*)(ws + WS_SCAL); float* ROPE = SCAL + 1024;
    float* AFF = (float*)(ws + WS_AFF); int* ROWID = (int*)(ws + WS_ROWID); float* GV = (float*)(ws + WS_GV); int* SLOT = (int*)(ws + WS_SLOT);
    bf16_t* WIN_T = (bf16_t*)(ws + WS_WIN); bf16_t* WOUT_T = (bf16_t*)(ws + WS_WOUT); unsigned char* WGUQ = ws + WS_WGU; unsigned char* WDQ = ws + WS_WD; bf16_t* X1 = (bf16_t*)(ws + WS_X1);
    unsigned char* HN8 = ws + WS_HN8; unsigned char* WIN8 = ws + WS_WIN8; bf16_t* HN = (bf16_t*)(ws + WS_HN); bf16_t* PB = (bf16_t*)(ws + WS_P); bf16_t* MIX = (bf16_t*)(ws + WS_MIX); unsigned char* H2Q = ws + WS_H2;
    unsigned char* VT8 = ws + WS_VT; unsigned char* QN8 = ws + WS_QN; unsigned char* KN8 = ws + WS_KN; f32x2* CAGG = (f32x2*)(ws + WS_CAGG); unsigned char* HHQ = ws + WS_HH; unsigned char* YB = ws + WS_Y;
    const float* X = args.in[I_X]; float* OUT = args.out;

    for (int u = tid; u < (LDS_BYTES - LDSCTL_OFF) / 4; u += NTHREADS) ((LAS unsigned*)(lds + LDSCTL_OFF))[u] = 0u;
    __syncthreads();
    XcdBarrier bar; bar.bar = ctl + CW_BAR; bar.x = 0; bar.st = nullptr;
    if (MK_N_LAUNCHES == 1) bar = xcd_barrier_post(ctl + CW_BAR, MISC + 8);
    const int lo = args.ph_lo, hi = args.ph_hi;
#ifndef PHASE_MASK
#define PHASE_MASK 0xfff
#endif
#define IN(k) (((PHASE_MASK >> (k)) & 1) && lo <= (k) && (k) < hi)
#define SEAM(k) do { if (IN(k) && IN((k) + 1)) xcd_barrier(bar); } while (0)

    if (IN(0)) {
        LAS float* scr = (LAS float*)(lds + wave * 8704);
        LAS float* sil = (LAS float*)(lds + 73728);
        for (int i = tid; i < 9 * 1024; i += NTHREADS) { const float v = (i < 8192) ? args.in[I_C][i] : args.in[I_CCTX][i - 8192]; sil[i] = siluf_(v); }
        __syncthreads();
        constexpr int I_IN = (D / 64) * (INW / 32), I_OUT = (D / 64) * (D / 32), I_ADA = 96 * 8, I_IN8 = (D / 64) * (1536 / 32);
        const bool p0bal = (G == 256);
        for (int rnd = 0; ; ++rnd) {
            const int it = p0bal ? (wave < 3 ? (rnd == 0 ? bx * 3 + wave : 1 << 30) : (rnd < 2 ? I_ADA + bx * 5 + (wave - 3) + rnd * 1280 : 1 << 30)) : gw + rnd * NGW;
            if (it >= I_IN + I_OUT + I_ADA + I_IN8) break;
            int r = it;
            if (r < I_ADA) {
                const int cg = r >> 3, ks = r & 7; const int col = cg * 64 + lane;
                float a[9];
#pragma unroll
                for (int b = 0; b < 9; ++b) a[b] = 0.f;
                const float* wp = args.in[I_WADA] + (size_t)(ks * 128) * (NMOD * D) + col;
#pragma unroll 4
                for (int k = 0; k < 128; ++k) { const float w = wp[(size_t)k * (NMOD * D)];
#pragma unroll
                    for (int b = 0; b < 9; ++b) a[b] += sil[b * 1024 + ks * 128 + k] * w; }
#pragma unroll
                for (int b = 0; b < 9; ++b) MODP[((size_t)ks * 9 + b) * (NMOD * D) + col] = a[b];
                continue;
            }
            r -= I_ADA;
            if (r < I_IN) { transpose_item<false>(args.in[I_WIN], D, INW, WIN_T, 0, scr, r, lane); continue; } r -= I_IN;
            if (r < I_IN8) { transpose_item<true>(args.in[I_WIN] + 1024, D, INW, WIN8, 0, scr, r, lane, 32.0f, 1536); continue; } r -= I_IN8;
            transpose_item<false>(args.in[I_WOUT], D, D, WOUT_T, 0, scr, r, lane);
        }
    }
    asm volatile("s_nop 0" ::: "memory");
    SEAM(0);

    if (IN(1)) {
        LAS float* modl = (LAS float*)lds;
        for (int i = tid; i < 9 * 2048; i += NTHREADS) { const int b = i >> 11, j = i & 2047; float s = args.in[I_BADA][j];
#pragma unroll
            for (int ks = 0; ks < 8; ++ks) s += MODP[((size_t)ks * 9 + b) * (NMOD * D) + j];
            modl[i] = (j < 1024) ? s : (1.0f + s) * args.in[I_N1G][j - 1024]; }
        for (int i = bx * NTHREADS + tid; i < 9 * NMOD * D; i += G * NTHREADS) { const int b = i / (NMOD * D), j = i % (NMOD * D); float s = args.in[I_BADA][j];
#pragma unroll
            for (int ks = 0; ks < 8; ++ks) s += MODP[((size_t)ks * 9 + b) * (NMOD * D) + j];
            MOD[i] = s; }
        if (bx == 0 && wave == 0) {
            const float d1 = wave_sum(args.in[I_LQ1][lane] * args.in[I_LK1][lane]), d2 = wave_sum(args.in[I_LQ2][lane] * args.in[I_LK2][lane]);
            if (lane == 0) SCAL[0] = expf(d1) - expf(d2) + LAM_INIT;
        }
        if (bx == 1) for (int i = tid; i < 1024; i += NTHREADS) { const int pos = i >> 4, p = i & 15; const float inv = exp2f(-(float)p * (13.287712379549449f / 16.0f)); const float ang = (float)pos * inv;
            ROPE[i] = __cosf(ang); ROPE[1024 + i] = __sinf(ang); }
        __syncthreads();
        {
            f32x4 g1[4];
#pragma unroll
            for (int j = 0; j < 4; ++j) g1[j] = *(const f32x4*)(args.in[I_N1G] + 4 * (64 * j + lane));
            f32x4 nv[4];
#define P1_ROWPTR(mm) ((mm) < ML ? X + (size_t)(mm) * D : args.in[I_CTX] + (size_t)((mm) - ML) * D)
            f32x4 nv1[4], nv2[4];
#pragma unroll
            for (int j = 0; j < 4; ++j) { nv[j] = (gw < MT) ? __builtin_nontemporal_load((const f32x4*)(P1_ROWPTR(gw) + 4 * (64 * j + lane))) : (f32x4){0.f, 0.f, 0.f, 0.f};
                nv1[j] = (gw + NGW < MT) ? __builtin_nontemporal_load((const f32x4*)(P1_ROWPTR(gw + NGW) + 4 * (64 * j + lane))) : (f32x4){0.f, 0.f, 0.f, 0.f};
                nv2[j] = (gw + 2 * NGW < MT) ? __builtin_nontemporal_load((const f32x4*)(P1_ROWPTR(gw + 2 * NGW) + 4 * (64 * j + lane))) : (f32x4){0.f, 0.f, 0.f, 0.f}; }
            for (int m = gw; m < MT; m += NGW) {
                const int b = m < ML ? (m >> 12) : 8;
                f32x4 v[4]; float ss = 0.f;
#pragma unroll
                for (int j = 0; j < 4; ++j) { v[j] = nv[j]; nv[j] = nv1[j]; nv1[j] = nv2[j]; }
                if (m + 3 * NGW < MT) {
#pragma unroll
                    for (int j = 0; j < 4; ++j) nv2[j] = __builtin_nontemporal_load((const f32x4*)(P1_ROWPTR(m + 3 * NGW) + 4 * (64 * j + lane))); }
#pragma unroll
                for (int j = 0; j < 4; ++j) ss += (v[j].x * v[j].x + v[j].y * v[j].y) + (v[j].z * v[j].z + v[j].w * v[j].w);
                const float rstd = __builtin_amdgcn_rsqf(wave_sum(ss) * (1.0f / D) + EPS);
#pragma unroll
                for (int j = 0; j < 4; ++j) { const int col = 4 * (64 * j + lane);
                    const f32x4 sh = *(const LAS f32x4*)(modl + b * 2048 + col), sc = *(const LAS f32x4*)(modl + b * 2048 + 1024 + col);
                    const f32x4 y = (v[j] * rstd) * sc + sh;
                    u32x2 o; o.x = pk2(y.x, y.y); o.y = pk2(y.z, y.w); *(u32x2*)(HN + (size_t)m * D + col) = o;
                    *(unsigned*)(HN8 + (size_t)m * D + col) = pk4_fp8(y.x, y.y, y.z, y.w); }
            }
#undef P1_ROWPTR
        }
    }
    SEAM(1);

    if (IN(2)) {
        { pg8::InProjOrderA S; S.init(G, bx);
          pg8::EpiInProj<false> E{PB, QN8, KN8, ROPE, args.in[I_QG], args.in[I_KG], (LAS float*)(lds + 131072)};
          pg8::gemm_phase<pg8::EpiInProj<false>, pg8::InProjOrderA, false>(lds, HN, WIN_T, D, nullptr, S, E); }
        { pg8::InProjOrderB S; S.init(G, bx);
          pg8::EpiInProj<true> E{PB, QN8, KN8, ROPE, args.in[I_QG], args.in[I_KG], (LAS float*)(lds + 131072)};
          pg8::gemm_phase<pg8::EpiInProj<true>, pg8::InProjOrderB, false, 1>(lds, HN8, WIN8, D, nullptr, S, E); }
        if (G == 256 && bx >= 48) {
            __syncthreads();
            if (bx < 112) {
                const int task = bx - 48, b = task >> 3, part = task & 7; float* WLP = (float*)(ws + WS_WLP);
#pragma unroll
                for (int q = 0; q < 4; ++q) { const int i = part * 2048 + q * 512 + tid; const int e = i & 15, k = i >> 4;
                    const float gs = args.in[I_N2G][k] * (1.0f + MOD[(size_t)b * (NMOD * D) + 4 * D + k]);
                    WLP[(size_t)b * 16384 + (2 * (k >> 5) + ((k >> 2) & 1)) * 256 + e * 16 + 4 * ((k >> 3) & 3) + (k & 3)] = gs * args.in[I_WR][i]; }
                if (wave < 2) { const int e = 2 * part + wave; float a = 0.f;
#pragma unroll
                    for (int j = 0; j < 16; ++j) { const int k = lane + 64 * j; a += MOD[(size_t)b * (NMOD * D) + 3 * D + k] * args.in[I_WR][k * 16 + e]; }
                    a = wave_sum(a); if (lane == 0) WLP[8 * 16384 + 65536 + b * 16 + e] = a; }
            }
            if (bx >= 112 && bx < 176) {
                const int task = bx - 112, n = task >> 3, part = task & 7; unsigned char* LWI = ws + WS_LWI + (size_t)n * 36864;
#pragma unroll
                for (int q = 0; q < 4; ++q) { const int i = part * 2048 + q * 512 + tid; const int mat = i >> 12, w = (i >> 6) & 63, v = i & 63; const int d = mat >> 1;
                    const float* src = (mat & 1) ? args.in[I_WI] : args.in[I_WA]; const float x = src[((size_t)(d * 8 + n) * 64 + w) * 64 + v];
                    *(bf16_t*)(LWI + (mat * 64 + v) * 144 + w * 2) = (bf16_t)f2bf(x); }
            }
            LAS float* scr = (LAS float*)(lds + wave * 16384);
            for (int it = CONV_NGU - (256 - bx) * CONV_P2 + wave; it < CONV_NGU - (255 - bx) * CONV_P2; it += NWAVES) conv_item(args, WGUQ, WDQ, scr, gu_it(it), lane);
        }
    }
    SEAM(2);

    if (IN(3)) {
        {
            LAS bf16_t* vs = (LAS bf16_t*)(lds + wave * 16896);
            for (int it = NGW - 1 - gw; it < NB * 4 * 68; it += NGW) {
                const int tile = it % 68, h = (it / 68) & 3, b = it / 272;
                const size_t row0 = tile < 4 ? (size_t)(ML + b * CTX + tile * 64) : (size_t)(b * SEQ + (tile - 4) * 64);
#pragma unroll 4
                for (int i = 0; i < 16; ++i) { const int key = 4 * i + (lane >> 4), c16 = lane & 15;
                    const u32x4 w = *(const u32x4*)(PB + (row0 + key) * INW + 2048 + h * 128 + c16 * 8);
                    LAS unsigned* d = (LAS unsigned*)(vs + key * 132 + c16 * 8); d[0] = w.x; d[1] = w.y; d[2] = w.z; d[3] = w.w; }
                LDS_WAIT(); asm volatile("" ::: "memory");
                const int er = lane >> 2, pq = lane & 3; const int kb0 = 4 * (pq >> 1) + 32 * (pq & 1);
#pragma unroll 2
                for (int i = 0; i < 4; ++i) { const int e = 32 * i + 2 * er; unsigned kw[16];
#pragma unroll
                    for (int jj = 0; jj < 16; ++jj) kw[jj] = *(const LAS unsigned*)(vs + (kb0 + (jj & 3) + 8 * (jj >> 2)) * 132 + e);
                    u32x4 o0, o1;
                    o0.x = pk4_fp8u(bflo(kw[0]), bflo(kw[1]), bflo(kw[2]), bflo(kw[3])); o0.y = pk4_fp8u(bflo(kw[4]), bflo(kw[5]), bflo(kw[6]), bflo(kw[7]));
                    o0.z = pk4_fp8u(bflo(kw[8]), bflo(kw[9]), bflo(kw[10]), bflo(kw[11])); o0.w = pk4_fp8u(bflo(kw[12]), bflo(kw[13]), bflo(kw[14]), bflo(kw[15]));
                    o1.x = pk4_fp8u(bfhi(kw[0]), bfhi(kw[1]), bfhi(kw[2]), bfhi(kw[3])); o1.y = pk4_fp8u(bfhi(kw[4]), bfhi(kw[5]), bfhi(kw[6]), bfhi(kw[7]));
                    o1.z = pk4_fp8u(bfhi(kw[8]), bfhi(kw[9]), bfhi(kw[10]), bfhi(kw[11])); o1.w = pk4_fp8u(bfhi(kw[12]), bfhi(kw[13]), bfhi(kw[14]), bfhi(kw[15]));
                    unsigned char* dst = VT8 + ((size_t)((b * 4 + h) * 128 + e) * 4352 + tile * 64 + pq * 16);
                    *(u32x4*)dst = o0; *(u32x4*)(dst + 4352) = o1; }
                LDS_WAIT(); asm volatile("" ::: "memory");
            }
            __syncthreads();
        }
        {
            const LAS unsigned char* WL = lds; LAS unsigned char* xct = lds + 36864 + wave * 9216;
            const int n = bx & 7, ngrp = G >> 3, jg = bx >> 3;
            if (G == 256) { const u32x4* LWI = (const u32x4*)(ws + WS_LWI + (size_t)n * 36864); for (int i = tid; i < 36864 / 16; i += NTHREADS) ((LAS u32x4*)lds)[i] = LWI[i]; }
            else lru_load_weights(lds, args.in[I_WA], args.in[I_WI], n, tid);
            __syncthreads();
            if (G == 256) {
                for (int it = jg * NWAVES + wave; it < 2 * ngrp * NWAVES; it += ngrp * NWAVES)
                    lru_item<0>(WL, xct, PB, MIX, CAGG, args.in[I_CONVW], args.in[I_CONVB], args.in[I_BA], args.in[I_BI], args.in[I_LAM], n, it / 68, it % 68, lane, 0.f, 0.f);
                if (wave == 0) { const int it = 2 * ngrp * NWAVES + jg;
                    lru_item<0>(WL, xct, PB, MIX, CAGG, args.in[I_CONVW], args.in[I_CONVB], args.in[I_BA], args.in[I_BI], args.in[I_LAM], n, it / 68, it % 68, lane, 0.f, 0.f); }
                else { const int i0 = CONV_NP8 + (n * 224 + jg * 7 + wave - 1) * CONV_P3;
                    for (int k = 0; k < 2 * CONV_P3; ++k) conv_item_half(args, WGUQ, WDQ, (LAS float*)xct, gu_it(i0 + (k >> 1)), k & 1, lane); }
            } else if (jg < ngrp) for (int it = jg * NWAVES + wave; it < NB * 68; it += ngrp * NWAVES)
                lru_item<0>(WL, xct, PB, MIX, CAGG, args.in[I_CONVW], args.in[I_CONVB], args.in[I_BA], args.in[I_BI], args.in[I_LAM], n, it / 68, it % 68, lane, 0.f, 0.f);
        }
    }
    SEAM(3);

    if (IN(5)) {
        for (int vbk = bx; vbk < 256; vbk += G) {
            const LAS unsigned char* WL = lds; LAS unsigned char* xct = lds + 36864 + wave * 9216; LAS f32x2* T = (LAS f32x2*)(lds + 110592);
            const int n = vbk & 7, b = (vbk >> 3) & 7, qtr = vbk >> 6;
            __syncthreads();
            if (G == 256) { const u32x4* LWI = (const u32x4*)(ws + WS_LWI + (size_t)n * 36864); for (int i = tid; i < 36864 / 16; i += NTHREADS) ((LAS u32x4*)lds)[i] = LWI[i]; }
            else lru_load_weights(lds, args.in[I_WA], args.in[I_WI], n, tid);
            float hcf[2], hcb[2];
#pragma unroll
            for (int d = 0; d < 2; ++d) {
                for (int i = tid; i < 68 * 64; i += NTHREADS) T[i] = CAGG[((size_t)(b * 68 + (i >> 6)) * 2 + d) * 512 + n * 64 + (i & 63)];
                __syncthreads();
                if (wave == 0) { float h = 0.f;
#pragma unroll 1
                    for (int bt = 0; bt < 4; ++bt) { f32x2 c[17]; float hin[17];
#pragma unroll
                        for (int i = 0; i < 17; ++i) { const int s = bt * 17 + i; const int j = (d == 0) ? s : (s < 4 ? 3 - s : 71 - s); c[i] = T[j * 64 + lane]; }
#pragma unroll
                        for (int i = 0; i < 17; ++i) { hin[i] = h; h = c[i].x * h + c[i].y; }
#pragma unroll
                        for (int i = 0; i < 17; ++i) { const int s = bt * 17 + i; const int j = (d == 0) ? s : (s < 4 ? 3 - s : 71 - s); T[j * 64 + lane].x = hin[i]; } } }
                __syncthreads();
#pragma unroll
                for (int k = 0; k < 2; ++k) { const float v = T[(4 + qtr * 16 + wave + 8 * k) * 64 + lane].x; if (d == 0) hcf[k] = v; else hcb[k] = v; }
                __syncthreads();
            }
#pragma unroll 1
            for (int k = 0; k < 2; ++k)
                lru_item<1>(WL, xct, PB, MIX, CAGG, args.in[I_CONVW], args.in[I_CONVB], args.in[I_BA], args.in[I_BI], args.in[I_LAM], n, b, 4 + qtr * 16 + wave + 8 * k, lane, k == 0 ? hcf[0] : hcf[1], k == 0 ? hcb[0] : hcb[1]);
        }
        __syncthreads();
#ifdef ATT_VARIANT
#endif
        att8_phase(lds, QN8, KN8, VT8, MIX, args.in[I_SUBG], SCAL[0], vcu, G, tid, lane, wave);
    }
    SEAM(5);

    if (IN(6)) {
        pg8::StaticOrder S; S.init(ML, D, G, bx);
        pg8::EpiResid E{X, X1, MOD, 2};
        pg8::gemm_phase<pg8::EpiResid, pg8::StaticOrder, false>(lds, MIX, WOUT_T, D, nullptr, S, E);
    }
    SEAM(6);

    if (IN(7)) {
        {
            LAS float* Wl = (LAS float*)lds;
            LAS float* Gs = (LAS float*)(lds + 65536);
            LAS float* Shs = (LAS float*)(lds + 69632);
            LAS float* cpart = (LAS float*)(lds + 73728);
            int bprev = -1;
            for (int rb = gw; rb < ML / 16; rb += NGW) {
                const int b = rb >> 8;
                if (b != bprev && G == 256) {
                    __syncthreads();
                    const float* WLP = (const float*)(ws + WS_WLP);
                    for (int k = tid; k < D; k += NTHREADS) { Gs[k] = args.in[I_N2G][k] * (1.0f + MOD[(size_t)b * (NMOD * D) + 4 * D + k]); Shs[k] = MOD[(size_t)b * (NMOD * D) + 3 * D + k]; }
#pragma unroll
                    for (int q = 0; q < 8; ++q) ((LAS f32x4*)Wl)[q * 512 + tid] = *(const f32x4*)(WLP + (size_t)b * 16384 + 4 * (q * 512 + tid));
                    if (tid < 16) cpart[tid] = WLP[8 * 16384 + 65536 + b * 16 + tid];
                    if (tid >= 16 && tid < 256) cpart[tid] = 0.f;
                    __syncthreads();
                    bprev = b;
                }
                if (b != bprev) {
                    __syncthreads();
                    for (int k = tid; k < D; k += NTHREADS) { Gs[k] = args.in[I_N2G][k] * (1.0f + MOD[(size_t)b * (NMOD * D) + 4 * D + k]); Shs[k] = MOD[(size_t)b * (NMOD * D) + 3 * D + k]; }
                    __syncthreads();
                    for (int i = tid; i < 16 * D; i += NTHREADS) { const int e = i & 15, k = i >> 4;
                        Wl[(2 * (k >> 5) + ((k >> 2) & 1)) * 256 + e * 16 + 4 * ((k >> 3) & 3) + (k & 3)] = Gs[k] * args.in[I_WR][i]; }
                    if (tid < 256) { const int e = tid & 15, part = tid >> 4; float a = 0.f; for (int k = part * 64; k < part * 64 + 64; ++k) a += Shs[k] * args.in[I_WR][k * 16 + e]; cpart[part * 16 + e] = a; }
                    __syncthreads();
                    bprev = b;
                }
                const int row = lane & 15, kq = lane >> 4;
                const bf16_t* xrow = X1 + (size_t)(16 * rb + row) * D + 8 * kq;
                f32x4 acc = (f32x4){0.f, 0.f, 0.f, 0.f}; float ssq = 0.f;
#pragma unroll 4
                for (int s8 = 0; s8 < 32; ++s8) {
                    const u32x4 xw = *(const u32x4*)(xrow + 32 * s8);
                    const f32x4 w0 = *(const LAS f32x4*)(Wl + (2 * s8) * 256 + row * 16 + 4 * kq), w1 = *(const LAS f32x4*)(Wl + (2 * s8 + 1) * 256 + row * 16 + 4 * kq);
                    const float xa[8] = {bflo(xw.x), bfhi(xw.x), bflo(xw.y), bfhi(xw.y), bflo(xw.z), bfhi(xw.z), bflo(xw.w), bfhi(xw.w)};
#pragma unroll
                    for (int j = 0; j < 4; ++j) { acc = __builtin_amdgcn_mfma_f32_16x16x4f32(xa[j], w0[j], acc, 0, 0, 0); ssq += xa[j] * xa[j]; }
#pragma unroll
                    for (int j = 0; j < 4; ++j) { acc = __builtin_amdgcn_mfma_f32_16x16x4f32(xa[4 + j], w1[j], acc, 0, 0, 0); ssq += xa[4 + j] * xa[4 + j]; }
                }
                ssq += __shfl_xor(ssq, 16); ssq += __shfl_xor(ssq, 32);
                const float rstd = __builtin_amdgcn_rsqf(ssq * (1.0f / D) + EPS);
                float cv = 0.f;
#pragma unroll
                for (int p = 0; p < 16; ++p) cv += cpart[p * 16 + row];
#pragma unroll
                for (int r = 0; r < 4; ++r) {
                    const float lg = __shfl(rstd, 4 * kq + r) * acc[r] + cv;
                    float mx = lg;
#pragma unroll
                    for (int o = 1; o < 16; o <<= 1) mx = fmaxf(mx, __shfl_xor(mx, o));
                    const float pe = __expf(lg - mx); float sum = pe;
#pragma unroll
                    for (int o = 1; o < 16; o <<= 1) sum += __shfl_xor(sum, o);
                    AFF[((size_t)(16 * rb + 4 * kq + r)) * 16 + row] = pe / sum;
                }
#pragma unroll 2
                for (int rr = 0; rr < 16; ++rr) {
                    const float rs = __builtin_bit_cast(float, __builtin_amdgcn_readlane(__builtin_bit_cast(int, rstd), rr));
                    const size_t m = (size_t)(16 * rb + rr);
#pragma unroll
                    for (int j = 0; j < 2; ++j) { const int col = 8 * (64 * j + lane);
                        const u32x4 xw = *(const u32x4*)(X1 + m * D + col);
                        const f32x4 g0 = *(const LAS f32x4*)(Gs + col), g1 = *(const LAS f32x4*)(Gs + col + 4), sh0 = *(const LAS f32x4*)(Shs + col), sh1 = *(const LAS f32x4*)(Shs + col + 4);
                        const f32x4 y0 = (f32x4){bflo(xw.x), bfhi(xw.x), bflo(xw.y), bfhi(xw.y)} * rs * g0 + sh0, y1 = (f32x4){bflo(xw.z), bfhi(xw.z), bflo(xw.w), bfhi(xw.w)} * rs * g1 + sh1;
                        u32x2 o; o.x = pk4_fp8(y0.x, y0.y, y0.z, y0.w); o.y = pk4_fp8(y1.x, y1.y, y1.z, y1.w);
                        *(u32x2*)(H2Q + m * D + col) = o; }
                }
            }
        }
    }
    SEAM(7);

    if (IN(8)) {
        LAS unsigned* hist = (LAS unsigned*)lds;
        LAS unsigned* sh = (LAS unsigned*)(lds + 1024);
        for (int lst = bx; lst < NB * NE; lst += G) {
            const int b = lst >> 4, e = lst & 15;
            const float* av = AFF + (size_t)b * SEQ * 16 + e;
            unsigned key[8];
#pragma unroll
            for (int i = 0; i < 8; ++i) key[i] = __builtin_bit_cast(unsigned, av[(size_t)(tid * 8 + i) * 16]);
            unsigned prefix = 0u, kk = CAP;
            for (int pass = 0; pass < 4; ++pass) {
                const int shift = 24 - 8 * pass; const unsigned himask = pass == 0 ? 0u : (0xffffffffu << (shift + 8));
                if (tid < 256) hist[tid] = 0u;
                __syncthreads();
#pragma unroll
                for (int i = 0; i < 8; ++i) if ((key[i] & himask) == prefix) atomicAdd((unsigned*)&hist[(key[i] >> shift) & 255u], 1u);
                __syncthreads();
                if (tid < 256) { const unsigned c = hist[255 - tid]; unsigned inc = c;
#pragma unroll
                    for (int o = 1; o < 64; o <<= 1) { const unsigned t2 = __shfl_up(inc, o); if (lane >= o) inc += t2; }
                    if (lane == 63) sh[48 + wave] = inc;
                    sh[64 + tid] = inc; sh[320 + tid] = c; }
                __syncthreads();
                if (tid < 256) { unsigned base = 0u; for (int w = 0; w < wave; ++w) base += sh[48 + w];
                    const unsigned inc = sh[64 + tid] + base, c = sh[320 + tid];
                    if (inc >= kk && inc - c < kk) { sh[0] = prefix | ((unsigned)(255 - tid) << shift); sh[1] = kk - (inc - c); } }
                __syncthreads();
                prefix = sh[0]; kk = sh[1];
                __syncthreads();
            }
            int ce = 0;
#pragma unroll
            for (int i = 0; i < 8; ++i) ce += (key[i] == prefix) ? 1 : 0;
            int inc = ce;
#pragma unroll
            for (int o = 1; o < 64; o <<= 1) { const int t2 = __shfl_up(inc, o); if (lane >= o) inc += t2; }
            if (lane == 63) sh[16 + wave] = (unsigned)inc;
            __syncthreads();
            int ebase = inc - ce;
            for (int w = 0; w < wave; ++w) ebase += (int)sh[16 + w];
            int cs = 0; unsigned selmask = 0u; int er = ebase;
#pragma unroll
            for (int i = 0; i < 8; ++i) { bool s = key[i] > prefix; if (key[i] == prefix) { s = er < (int)kk; ++er; } if (s) { selmask |= 1u << i; ++cs; } }
            int inc2 = cs;
#pragma unroll
            for (int o = 1; o < 64; o <<= 1) { const int t2 = __shfl_up(inc2, o); if (lane >= o) inc2 += t2; }
            if (lane == 63) sh[32 + wave] = (unsigned)inc2;
            __syncthreads();
            int sbase = inc2 - cs;
            for (int w = 0; w < wave; ++w) sbase += (int)sh[32 + w];
#pragma unroll
            for (int i = 0; i < 8; ++i) { const int t = tid * 8 + i; int slot = -1;
                if (selmask & (1u << i)) { slot = sbase++; ROWID[(e * NB + b) * CAP + slot] = b * SEQ + t; GV[(e * NB + b) * CAP + slot] = __builtin_bit_cast(float, key[i]); }
                ((short*)SLOT)[((size_t)b * SEQ + t) * 16 + e] = (short)slot; }
            __syncthreads();
        }
        __syncthreads();
        {
            LAS float* scr = (LAS float*)(lds + wave * 16384);
            const int NIT = (G == 256) ? CONV_NP8 : CONV_NIT;
            int it0, it1;
            if (G == 256) { constexpr int N1 = 35, LO = 128 * N1; if (bx < 128) { it0 = N1 * bx; it1 = it0 + N1; } else { it0 = LO + (int)((long)(CONV_NP8 - LO) * (bx - 128) / 128); it1 = LO + (int)((long)(CONV_NP8 - LO) * (bx - 127) / 128); } }
            else { it0 = (int)((long)NIT * bx / G); it1 = (int)((long)NIT * (bx + 1) / G); }
            for (int it = it0 + wave; it < it1; it += NWAVES) conv_item(args, WGUQ, WDQ, scr, (G == 256) ? gu_it(it) : it, lane);
        }
    }
    SEAM(8);

    if (IN(9)) {
        pg8::StaticOrder S; S.init(NE * NB * CAP, GU_N, G, bx, 16, GU_N / 256);
        pg8::EpiSwiGLU8 E{HHQ, (G == 256) ? args.in[I_WDN] : nullptr, WDQ, (LAS float*)(lds + RING_BYTES + wave * 2048), (bx * NWAVES + wave) * 11, 0};
        pg8::gemm_phase<pg8::EpiSwiGLU8, pg8::StaticOrder, true, 1, false>(lds, H2Q, WGUQ, D, ROWID, S, E);
    }
    SEAM(9);

    if (IN(10)) {
        pg8::StaticOrder S; S.init(NE * NB * CAP, D, G, bx, 16, D / 256);
        pg8::EpiScaleBf16 E{YB, GV, 32.0f / 256.0f};
        pg8::gemm_phase<pg8::EpiScaleBf16, pg8::StaticOrder, false, 1>(lds, HHQ, WDQ, DE, nullptr, S, E);
    }
    SEAM(10);

    if (IN(11)) {
        LAS short* sl = (LAS short*)(lds + wave * 512);
        const short* SLOT16 = (const short*)SLOT;
        for (int m0 = gw * 16; m0 < ML; m0 += NGW * 16) {
            const int b = m0 >> 12;
            *(LAS u32x2*)((LAS unsigned char*)sl + lane * 8) = *(const u32x2*)((const unsigned char*)SLOT16 + (size_t)m0 * 32 + lane * 8);
            f32x4 g[2][2];
#pragma unroll
            for (int j = 0; j < 2; ++j) { g[j][0] = *(const f32x4*)(MOD + (size_t)b * (NMOD * D) + 5 * D + 8 * (64 * j + lane)); g[j][1] = *(const f32x4*)(MOD + (size_t)b * (NMOD * D) + 5 * D + 8 * (64 * j + lane) + 4); }
            LDS_WAIT(); asm volatile("" ::: "memory");
            u32x4 nx[2];
#pragma unroll
            for (int j = 0; j < 2; ++j) nx[j] = *(const u32x4*)(X1 + (size_t)m0 * D + 8 * (64 * j + lane));
#define P11_ISSUE(SV, MK, W, WV) do { _Pragma("unroll") for (int q = 0; q < 4; ++q) { const bool v_ = MK != 0u; const int e_ = v_ ? __builtin_ctz(MK) : 0; MK = v_ ? (MK & (MK - 1u)) : 0u; \
                int sx_ = __builtin_amdgcn_readlane(SV, e_); sx_ = v_ ? sx_ : 0; const unsigned char* yp_ = YB + ((size_t)(e_ * NB + b) * CAP + sx_) * D; WV[q] = v_ ? (1.0f / 32.0f) : 0.0f; \
                if (v_) { _Pragma("unroll") for (int j = 0; j < 2; ++j) W[q][j] = *(const u32x2*)(yp_ + 8 * (64 * j + lane)); } \
                else    { _Pragma("unroll") for (int j = 0; j < 2; ++j) W[q][j] = (u32x2){0u, 0u}; } } } while (0)
#define P11_ACC(W, WV) do { _Pragma("unroll") for (int q = 0; q < 4; ++q) _Pragma("unroll") for (int j = 0; j < 2; ++j) { \
                const f32x2 p0 = __builtin_amdgcn_cvt_pk_f32_fp8((int)W[q][j].x, false), p1 = __builtin_amdgcn_cvt_pk_f32_fp8((int)W[q][j].x, true), p2 = __builtin_amdgcn_cvt_pk_f32_fp8((int)W[q][j].y, false), p3 = __builtin_amdgcn_cvt_pk_f32_fp8((int)W[q][j].y, true); \
                a[j][0] += WV[q] * (f32x4){p0.x, p0.y, p1.x, p1.y}; a[j][1] += WV[q] * (f32x4){p2.x, p2.y, p3.x, p3.y}; } } while (0)
            int svn = (lane < 16) ? (int)sl[lane] : -1; unsigned mkn = (unsigned)(__ballot(svn >= 0) & 0xffffull);
            u32x2 wn[4][2]; float wvn[4];
            P11_ISSUE(svn, mkn, wn, wvn);
#pragma unroll 1
            for (int r = 0; r < 16; ++r) {
                const int m = m0 + r;
                u32x4 xv[2]; u32x2 w[4][2]; float wv[4];
#pragma unroll
                for (int j = 0; j < 2; ++j) xv[j] = nx[j];
#pragma unroll
                for (int q = 0; q < 4; ++q) { wv[q] = wvn[q];
#pragma unroll
                    for (int j = 0; j < 2; ++j) w[q][j] = wn[q][j]; }
                const int sv = svn; unsigned mk = mkn;
                if (r < 15) {
#pragma unroll
                    for (int j = 0; j < 2; ++j) nx[j] = *(const u32x4*)(X1 + (size_t)(m + 1) * D + 8 * (64 * j + lane));
                    svn = (lane < 16) ? (int)sl[(r + 1) * 16 + lane] : -1; mkn = (unsigned)(__ballot(svn >= 0) & 0xffffull);
                    P11_ISSUE(svn, mkn, wn, wvn); }
                f32x4 a[2][2];
#pragma unroll
                for (int j = 0; j < 2; ++j) { a[j][0] = (f32x4){0.f, 0.f, 0.f, 0.f}; a[j][1] = (f32x4){0.f, 0.f, 0.f, 0.f}; }
                P11_ACC(w, wv);
                while (mk != 0u) { P11_ISSUE(sv, mk, w, wv); P11_ACC(w, wv); }
#pragma unroll
                for (int j = 0; j < 2; ++j) { float* op = OUT + (size_t)m * D + 8 * (64 * j + lane);
                    *(f32x4*)op = (f32x4){bflo(xv[j].x), bfhi(xv[j].x), bflo(xv[j].y), bfhi(xv[j].y)} + g[j][0] * a[j][0];
                    *(f32x4*)(op + 4) = (f32x4){bflo(xv[j].z), bfhi(xv[j].z), bflo(xv[j].w), bfhi(xv[j].w)} + g[j][1] * a[j][1]; }
            }
#undef P11_ISSUE
#undef P11_ACC
            LDS_WAIT(); asm volatile("" ::: "memory");
        }
    }
#undef IN
#undef SEAM
}

constexpr int N_PHASES = 12;

extern "C" void kernel_launch(void* const* d_in, const int* in_sizes, int n_in, void* d_out, int out_size, void* d_ws, size_t ws_size, hipStream_t stream) {
    static int grid = 0;
    if (grid == 0) {
        if (n_in != 28 || out_size != ML * D || ws_size < WS_END) { fprintf(stderr, "kernel_launch: unexpected shapes: n_in %d out %d ws %zu (need %zu)\n", n_in, out_size, ws_size, (size_t)WS_END); grid = -1; return; }
        int dev = 0, cus = 0;
        if (hipGetDevice(&dev) != hipSuccess || hipDeviceGetAttribute(&cus, hipDeviceAttributeMultiprocessorCount, dev) != hipSuccess) { grid = -1; return; }
        if (hipFuncSetAttribute((const void*)mk_fwd, hipFuncAttributeMaxDynamicSharedMemorySize, LDS_BYTES) != hipSuccess) { fprintf(stderr, "kernel_launch: hipFuncSetAttribute failed\n"); grid = -1; return; }
        int per_cu = 0;
        if (hipOccupancyMaxActiveBlocksPerMultiprocessor(&per_cu, (const void*)mk_fwd, NTHREADS, LDS_BYTES) != hipSuccess || per_cu < 1) fprintf(stderr, "kernel_launch: occupancy query says %d\n", per_cu);
        (void)hipGetLastError();
        grid = cus;
    }
    if (grid < 0) return;
    hipMemsetAsync((char*)d_ws + WS_CTL, 0, CTL_ZERO_BYTES, stream);
    Args a{};
    for (int i = 0; i < 28; ++i) a.in[i] = (const float*)d_in[i];
    a.out = (float*)d_out; a.ws = (unsigned char*)d_ws;
    if (MK_N_LAUNCHES == 1) {
        a.ph_lo = 0; a.ph_hi = N_PHASES; a.li = 0;
        hipLaunchKernelGGL(mk_fwd, dim3(grid), dim3(NTHREADS), LDS_BYTES, stream, a);
    } else {
        for (int p = 0; p < N_PHASES; ++p) { a.ph_lo = p; a.ph_hi = p + 1; a.li = 0; hipLaunchKernelGGL(mk_fwd, dim3(grid), dim3(NTHREADS), LDS_BYTES, stream, a); }
    }
}
```
